# Optimizing an MI355X kernel written in HIP

```python
import math
import jax, jax.numpy as jnp
from jax import lax
import numpy as np

D_MODEL = 1024
BATCH = 4
SEQ = 8192
DEPTH = 2

CTX_LEN = 256
GRID_W = 64
RET_HEADS = D_MODEL // 256
RET_DK = 256
RET_DV = 256
RET_CHUNK = 128
DIFF_HEADS = D_MODEL // 128
DIFF_HD = 64
DIFF_DV = 2 * DIFF_HD
NA_HEADS = D_MODEL // 64
NA_HD = 64
NA_KH = 8
NA_KW = 16
D_FF = 4 * D_MODEL
Q_BLOCK = 128
ROPE_BASE = 10000.0
LN_EPS = 1e-6
SUBLN_EPS = 1e-5

RET_QK_W = RET_HEADS * RET_DK
RET_V_W = RET_HEADS * RET_DV
DIFF_QK_W = 2 * DIFF_HEADS * DIFF_HD
DIFF_V_W = DIFF_HEADS * DIFF_DV
NA_W = NA_HEADS * NA_HD
IN_SIZES = (RET_QK_W, RET_QK_W, RET_V_W, RET_V_W, DIFF_QK_W, DIFF_QK_W, DIFF_V_W, NA_W, NA_W, NA_W, D_MODEL, D_MODEL, D_MODEL)
IN_WIDTH = 2 * RET_QK_W + 2 * RET_V_W + 2 * DIFF_QK_W + DIFF_V_W + 3 * NA_W + 3 * D_MODEL

kernel_name = 'hybrid_retention_diffattn_natten_dit_block'


def layer_norm(x, g=None, b=None, eps=LN_EPS):
    xf = x.astype(jnp.float32)
    mu = jnp.mean(xf, axis=-1, keepdims=True)
    var = jnp.mean(jnp.square(xf - mu), axis=-1, keepdims=True)
    y = (xf - mu) * lax.rsqrt(var + eps)
    if g is not None:
        y = y * g.astype(jnp.float32) + b.astype(jnp.float32)
    return y.astype(x.dtype)


def rms_norm(x, g, eps=SUBLN_EPS):
    xf = x.astype(jnp.float32)
    y = xf * lax.rsqrt(jnp.mean(jnp.square(xf), axis=-1, keepdims=True) + eps) * g.astype(jnp.float32)
    return y.astype(x.dtype)


def modulate(x, shift, scale):
    return layer_norm(x) * (1.0 + scale) + shift


def split_cols(z):
    idx = []
    acc = 0
    for s in IN_SIZES[:-1]:
        acc += s
        idx.append(acc)
    return jnp.split(z, idx, axis=-1)


def heads(a, n, d):
    b, L, _ = a.shape
    return a.reshape(b, L, n, d).transpose(0, 2, 1, 3)


def merge_heads(a):
    b, h, L, d = a.shape
    return a.transpose(0, 2, 1, 3).reshape(b, L, h * d)


def diff_qk_heads(a):
    b, L, _ = a.shape
    return a.reshape(b, L, DIFF_HEADS, 2, DIFF_HD).transpose(0, 2, 3, 1, 4)


def rope(x, ang):
    cos = jnp.cos(ang).astype(x.dtype)
    sin = jnp.sin(ang).astype(x.dtype)
    x1, x2 = jnp.split(x, 2, axis=-1)
    return jnp.concatenate([x1 * cos - x2 * sin, x1 * sin + x2 * cos], axis=-1)


def retention_angles(L):
    t = jnp.arange(L, dtype=jnp.float32)
    inv = ROPE_BASE ** (-jnp.linspace(0.0, 1.0, RET_DK // 2, dtype=jnp.float32))
    return t[:, None] * inv[None, :]


def axial_angles(L, hd):
    t = jnp.arange(L)
    row = (t // GRID_W).astype(jnp.float32)
    col = (t % GRID_W).astype(jnp.float32)
    half = hd // 2
    inv = ROPE_BASE ** (-jnp.arange(0, half, 2, dtype=jnp.float32) / half)
    return row[:, None] * inv[None, :], col[:, None] * inv[None, :]


def axial_rope(x, ang_r, ang_c):
    xr, xc = jnp.split(x, 2, axis=-1)
    return jnp.concatenate([rope(xr, ang_r), rope(xc, ang_c)], axis=-1)


def retention_scan(q, k, v, log_g, s0):
    b, h, L, dk = q.shape
    dv = v.shape[-1]
    C = RET_CHUNK
    n = L // C

    def chunks(a):
        return jnp.moveaxis(a.reshape(b, h, n, C, a.shape[-1]), 2, 0)

    i = jnp.arange(C, dtype=jnp.float32)
    lg = log_g[:, None]
    dist = i[:, None] - i[None, :]
    intra = jnp.where(dist >= 0, jnp.exp(lg[..., None] * jnp.maximum(dist, 0.0)), 0.0).astype(q.dtype)
    q_dec = jnp.exp(lg * (i + 1.0)).astype(q.dtype)
    k_dec = jnp.exp(lg * (C - 1.0 - i)).astype(q.dtype)
    c_dec = jnp.exp(log_g * C).astype(q.dtype)

    def step(s, xs):
        qc, kc, vc = xs
        att = jnp.einsum('bhid,bhjd->bhij', qc, kc) * intra
        o = jnp.einsum('bhij,bhjv->bhiv', att, vc) + jnp.einsum('bhid,bhdv->bhiv', qc * q_dec[:, :, None], s)
        s = s * c_dec[:, None, None] + jnp.einsum('bhjd,bhjv->bhdv', kc * k_dec[:, :, None], vc)
        return s, o

    s_fin, o = lax.scan(step, s0, (chunks(q), chunks(k), chunks(v)))
    o = jnp.moveaxis(o, 0, 2).reshape(b, h, L, dv)
    return s_fin, o


def retention_mixer(q_l, k_l, v_l, q_c, k_c, v_c, dec_f, dec_b, with_ctx_out):
    lg_f = jax.nn.log_sigmoid(dec_f.astype(jnp.float32))
    lg_b = jax.nn.log_sigmoid(dec_b.astype(jnp.float32))
    b, h, _, dk = q_c.shape
    s0 = jnp.zeros((b, h, dk, v_c.shape[-1]), v_c.dtype)
    rev = lambda a: jnp.flip(a, axis=2)
    s_cf, o_cf = retention_scan(q_c, k_c, v_c, lg_f, s0)
    s_cb, o_cb = retention_scan(rev(q_c), rev(k_c), rev(v_c), lg_b, s0)
    _, o_lf = retention_scan(q_l, k_l, v_l, lg_f, s_cf)
    _, o_lb = retention_scan(rev(q_l), rev(k_l), rev(v_l), lg_b, s_cb)
    o_l = o_lf + rev(o_lb)
    o_c = o_cf + rev(o_cb) if with_ctx_out else None
    return o_l, o_c


def diff_probs_out(q, k, v, lam):
    s = jnp.einsum('bhmqd,bhmkd->bhmqk', q, k).astype(jnp.float32)
    p = jax.nn.softmax(s, axis=-1)
    a = (p[:, :, 0] - lam * p[:, :, 1]).astype(v.dtype)
    return jnp.einsum('bhqk,bhkv->bhqv', a, v)


def sweep_query_blocks(fn, q, *rest):
    L = q.shape[-2]
    nb = L // Q_BLOCK
    qb = jnp.moveaxis(q.reshape(q.shape[:-2] + (nb, Q_BLOCK, q.shape[-1])), -3, 0)
    ob = lax.map(lambda blk: fn(blk, *rest), qb)
    ob = jnp.moveaxis(ob, 0, -3)
    return ob.reshape(ob.shape[:-3] + (L, ob.shape[-1]))


def diff_mixer(q_l, k_l, v_l, q_c, k_c, v_c, lq1, lk1, lq2, lk2, subln_g, layer_idx, with_ctx_out):
    lam_init = 0.8 - 0.6 * math.exp(-0.3 * layer_idx)
    f = lambda a: a.astype(jnp.float32)
    lam = jnp.exp(jnp.sum(f(lq1) * f(lk1))) - jnp.exp(jnp.sum(f(lq2) * f(lk2))) + lam_init
    k_all = jnp.concatenate([k_l, k_c], axis=3)
    v_all = jnp.concatenate([v_l, v_c], axis=2)
    post = lambda o: rms_norm(o, subln_g) * (1.0 - lam_init)
    o_l = post(sweep_query_blocks(diff_probs_out, q_l, k_all, v_all, lam))
    o_c = post(diff_probs_out(q_c, k_c, v_c, lam)) if with_ctx_out else None
    return o_l, o_c


def ctx_attention(q, k, v):
    p = jax.nn.softmax(jnp.einsum('bhqd,bhkd->bhqk', q, k).astype(jnp.float32), axis=-1).astype(v.dtype)
    return jnp.einsum('bhqk,bhkv->bhqv', p, v)


def na_mixer(q_l, k_l, v_l, q_c, k_c, v_c, rpb, with_ctx_out):
    b, h, L, d = q_l.shape
    rows = L // GRID_W
    kh = min(NA_KH, rows)
    kw = NA_KW
    grid = lambda a: a.reshape(b, h, rows, GRID_W, a.shape[-1])
    kg, vg = grid(k_l), grid(v_l)
    qg = jnp.moveaxis(grid(q_l), 2, 0)
    j = jnp.arange(GRID_W)
    cs = jnp.clip(j - kw // 2, 0, GRID_W - kw)
    col_mask = (j[None, :] >= cs[:, None]) & (j[None, :] < cs[:, None] + kw)
    col_idx = jnp.clip(j[None, :] - j[:, None] + NA_KW - 1, 0, 2 * NA_KW - 2)
    a = jnp.arange(kh)
    n_nb = kh * GRID_W

    def row_block(args):
        r, qr = args
        rs = jnp.clip(r - kh // 2, 0, rows - kh)
        kb = lax.dynamic_slice_in_dim(kg, rs, kh, axis=2)
        vb = lax.dynamic_slice_in_dim(vg, rs, kh, axis=2)
        row_idx = rs + a - r + NA_KH - 1
        bias = rpb[:, row_idx[None, :, None], col_idx[:, None, :]].astype(jnp.float32)
        s_nb = jnp.einsum('bhjd,bhakd->bhjak', qr, kb).astype(jnp.float32) + bias
        s_nb = jnp.where(col_mask[:, None, :], s_nb, -jnp.inf).reshape(b, h, GRID_W, n_nb)
        s_cx = jnp.einsum('bhjd,bhcd->bhjc', qr, k_c).astype(jnp.float32)
        p = jax.nn.softmax(jnp.concatenate([s_nb, s_cx], axis=-1), axis=-1).astype(vb.dtype)
        p_nb = p[..., :n_nb].reshape(b, h, GRID_W, kh, GRID_W)
        p_cx = p[..., n_nb:]
        return jnp.einsum('bhjak,bhakv->bhjv', p_nb, vb) + jnp.einsum('bhjc,bhcv->bhjv', p_cx, v_c)

    o = lax.map(row_block, (jnp.arange(rows), qg))
    o_l = jnp.moveaxis(o, 0, 2).reshape(b, h, L, d)
    o_c = ctx_attention(q_c, k_c, v_c) if with_ctx_out else None
    return o_l, o_c


def mixer_sublayer(h_l, h_c, w_in, dec_f, dec_b, lq1, lk1, lq2, lk2, subln_g, rpb, w_pa, w_pb, w_pc, w_o, layer_idx, with_ctx_out):
    L = h_l.shape[1]
    (rq_l, rk_l, rv_l, rg_l, dq_l, dk_l, dv_l, nq_l, nk_l, nv_l, ga_l, gb_l, gc_l) = split_cols(h_l @ w_in)
    (rq_c, rk_c, rv_c, rg_c, dq_c, dk_c, dv_c, nq_c, nk_c, nv_c, ga_c, gb_c, gc_c) = split_cols(h_c @ w_in)

    ang = retention_angles(L)
    rsc = RET_DK ** -0.5
    o_rl, o_rc = retention_mixer(
        rope(heads(rq_l, RET_HEADS, RET_DK), ang), rope(heads(rk_l, RET_HEADS, RET_DK), ang) * rsc, heads(rv_l, RET_HEADS, RET_DV),
        heads(rq_c, RET_HEADS, RET_DK), heads(rk_c, RET_HEADS, RET_DK) * rsc, heads(rv_c, RET_HEADS, RET_DV),
        dec_f, dec_b, with_ctx_out)

    ang_r, ang_c = axial_angles(L, DIFF_HD)
    dsc = DIFF_HD ** -0.5
    o_dl, o_dc = diff_mixer(
        axial_rope(diff_qk_heads(dq_l), ang_r, ang_c) * dsc, axial_rope(diff_qk_heads(dk_l), ang_r, ang_c), heads(dv_l, DIFF_HEADS, DIFF_DV),
        diff_qk_heads(dq_c) * dsc, diff_qk_heads(dk_c), heads(dv_c, DIFF_HEADS, DIFF_DV),
        lq1, lk1, lq2, lk2, subln_g, layer_idx, with_ctx_out)

    nsc = NA_HD ** -0.5
    o_nl, o_nc = na_mixer(
        heads(nq_l, NA_HEADS, NA_HD) * nsc, heads(nk_l, NA_HEADS, NA_HD), heads(nv_l, NA_HEADS, NA_HD),
        heads(nq_c, NA_HEADS, NA_HD) * nsc, heads(nk_c, NA_HEADS, NA_HD), heads(nv_c, NA_HEADS, NA_HD),
        rpb, with_ctx_out)

    def merge_branches(o_r, g_r, o_d, o_n, ga, gb, gc):
        y_a = (jax.nn.silu(g_r) * merge_heads(layer_norm(o_r))) @ w_pa
        y_b = merge_heads(o_d) @ w_pb
        y_c = merge_heads(o_n) @ w_pc
        m = jax.nn.sigmoid(ga) * y_a + jax.nn.sigmoid(gb) * y_b + jax.nn.sigmoid(gc) * y_c
        return m @ w_o

    y_l = merge_branches(o_rl, rg_l, o_dl, o_nl, ga_l, gb_l, gc_l)
    y_c = merge_branches(o_rc, rg_c, o_dc, o_nc, ga_c, gb_c, gc_c) if with_ctx_out else None
    return y_l, y_c


def sq_relu_ffn(h, w1, w2):
    return jnp.square(jax.nn.relu(h @ w1)) @ w2


def setup_inputs(seed: int = 0) -> dict:
    key = jax.random.key(seed)
    ks = jax.random.split(key, 26)
    f32 = jnp.float32
    nrm = lambda k, shape, s: s * jax.random.normal(k, shape, f32)
    beta = (8.0 * DEPTH) ** -0.25
    ret_init = jnp.asarray(np.log(2.0 ** (5.0 + np.arange(RET_HEADS)) - 1.0).astype(np.float32))
    return {
        'x': nrm(ks[0], (BATCH, SEQ, D_MODEL), 1.0),
        'c': nrm(ks[1], (BATCH, D_MODEL), 1.0),
        'ctx': nrm(ks[2], (BATCH, CTX_LEN, D_MODEL), 1.0),
        'c_ctx': nrm(ks[3], (D_MODEL,), 1.0),
        'w_mod': nrm(ks[4], (DEPTH, D_MODEL, 6 * D_MODEL), 0.5 * D_MODEL ** -0.5),
        'b_mod': nrm(ks[5], (DEPTH, 6 * D_MODEL), 0.01),
        'w_in': nrm(ks[6], (DEPTH, D_MODEL, IN_WIDTH), D_MODEL ** -0.5),
        'ret_decay_f': ret_init[None, :] + nrm(ks[7], (DEPTH, RET_HEADS), 0.01),
        'ret_decay_b': ret_init[None, :] + nrm(ks[8], (DEPTH, RET_HEADS), 0.01),
        'diff_lq1': nrm(ks[9], (DEPTH, DIFF_HD), 0.1),
        'diff_lk1': nrm(ks[10], (DEPTH, DIFF_HD), 0.1),
        'diff_lq2': nrm(ks[11], (DEPTH, DIFF_HD), 0.1),
        'diff_lk2': nrm(ks[12], (DEPTH, DIFF_HD), 0.1),
        'diff_subln_g': 1.0 + nrm(ks[13], (DEPTH, DIFF_DV), 0.01),
        'na_rpb': nrm(ks[14], (DEPTH, NA_HEADS, 2 * NA_KH - 1, 2 * NA_KW - 1), 0.05),
        'w_pa': nrm(ks[15], (DEPTH, RET_V_W, D_MODEL), RET_V_W ** -0.5),
        'w_pb': nrm(ks[16], (DEPTH, DIFF_V_W, D_MODEL), DIFF_V_W ** -0.5),
        'w_pc': nrm(ks[17], (DEPTH, NA_W, D_MODEL), NA_W ** -0.5),
        'w_o': nrm(ks[18], (DEPTH, D_MODEL, D_MODEL), beta * D_MODEL ** -0.5),
        'ln1_g': 1.0 + nrm(ks[19], (DEPTH, D_MODEL), 0.01),
        'ln1_b': nrm(ks[20], (DEPTH, D_MODEL), 0.01),
        'w_ff1': nrm(ks[21], (DEPTH, D_MODEL, D_FF), D_MODEL ** -0.5),
        'w_ff2': nrm(ks[22], (DEPTH, D_FF, D_MODEL), beta * D_FF ** -0.5),
        'ln2_g': 1.0 + nrm(ks[23], (DEPTH, D_MODEL), 0.01),
        'ln2_b': nrm(ks[24], (DEPTH, D_MODEL), 0.01),
    }


def reference(x, c, ctx, c_ctx, w_mod, b_mod, w_in, ret_decay_f, ret_decay_b, diff_lq1, diff_lk1, diff_lq2, diff_lk2, diff_subln_g, na_rpb, w_pa, w_pb, w_pc, w_o, ln1_g, ln1_b, w_ff1, w_ff2, ln2_g, ln2_b):
    alpha = (2.0 * DEPTH) ** 0.25
    x_l, x_c = x, ctx
    for l in range(DEPTH):
        with_ctx_out = l < DEPTH - 1
        mod_l = jax.nn.silu(c) @ w_mod[l] + b_mod[l]
        mod_c = jax.nn.silu(c_ctx) @ w_mod[l] + b_mod[l]
        sh1, sc1, g1, sh2, sc2, g2 = jnp.split(mod_l[:, None, :], 6, axis=-1)
        csh1, csc1, cg1, csh2, csc2, cg2 = jnp.split(mod_c, 6, axis=-1)

        h_l = modulate(x_l, sh1, sc1)
        h_c = modulate(x_c, csh1, csc1)
        y_l, y_c = mixer_sublayer(h_l, h_c, w_in[l], ret_decay_f[l], ret_decay_b[l], diff_lq1[l], diff_lk1[l], diff_lq2[l], diff_lk2[l],
                                  diff_subln_g[l], na_rpb[l], w_pa[l], w_pb[l], w_pc[l], w_o[l], l, with_ctx_out)
        x_l = layer_norm(alpha * x_l + g1 * y_l, ln1_g[l], ln1_b[l])
        x_l = layer_norm(alpha * x_l + g2 * sq_relu_ffn(modulate(x_l, sh2, sc2), w_ff1[l], w_ff2[l]), ln2_g[l], ln2_b[l])
        if with_ctx_out:
            x_c = layer_norm(alpha * x_c + cg1 * y_c, ln1_g[l], ln1_b[l])
            x_c = layer_norm(alpha * x_c + cg2 * sq_relu_ffn(modulate(x_c, csh2, csc2), w_ff1[l], w_ff2[l]), ln2_g[l], ln2_b[l])
    return x_l
```

```cpp
#include <hip/hip_runtime.h>
#include <hip/hip_cooperative_groups.h>
#include <cstdio>
#include <cstdint>
namespace cg = cooperative_groups;
#ifndef PIPE4
#define PIPE4 0
#endif
#ifndef FOLD_M
#define FOLD_M 1
#endif
#ifndef S2MASK
#define S2MASK 15
#endif

typedef unsigned short bf16_t;
typedef short bf16x8 __attribute__((ext_vector_type(8)));
typedef float f32x16 __attribute__((ext_vector_type(16)));
typedef unsigned u32x4 __attribute__((ext_vector_type(4)));
typedef unsigned u32x2 __attribute__((ext_vector_type(2)));
#define DI __device__ __forceinline__
#define MFMA(a, b, c) __builtin_amdgcn_mfma_f32_32x32x16_bf16((a), (b), (c), 0, 0, 0)
#define LAS __attribute__((address_space(3)))

constexpr int D = 1024, SEQ = 8192, CTXL = 256, NBATCH = 4, RB = 8448  ;
constexpr int ZLD = 10304, VLD = 8448, INW = 13312, DFF = 4096;
constexpr int HLD = 1088, OLD = 1088, WK = 1088, WK2 = 4160, ULD = 4160;
constexpr int ZC_RQ = 0, ZC_RK = 1024, ZC_RG = 2048, ZC_DQ = 3072, ZC_DK = 4096, ZC_NQ = 5120, ZC_NK = 6144, ZC_GA = 7168;
constexpr float L2E = 1.4426950408889634f;

constexpr size_t OFF_BAR = 0;
constexpr size_t OFF_WIN = 16384;
constexpr size_t OFF_WP  = OFF_WIN + 13312ull * WK * 2;
constexpr size_t OFF_WO  = OFF_WP + 3ull * 1024 * WK * 2;
constexpr size_t OFF_WF1 = OFF_WO + 1024ull * WK * 2;
constexpr size_t OFF_WF2 = OFF_WF1 + 4096ull * WK * 2;
constexpr size_t OFF_TAB = OFF_WF2 + 1024ull * WK2 * 2;
constexpr size_t OFF_MOD = OFF_TAB + 160ull * 8192 * 8;
constexpr size_t OFF_MISC = OFF_MOD + 2ull * 5 * 6144 * 4;
constexpr size_t OFF_XC = OFF_MISC + 4096;
constexpr size_t OFF_H = OFF_XC + 1024ull * 1024 * 4;
constexpr size_t OFF_Z = OFF_H + 33792ull * HLD * 2;
constexpr size_t OFF_VT = OFF_Z + 8448ull * ZLD * 2;
constexpr size_t OFF_KT = OFF_VT + 3072ull * 8448 * 2;
constexpr size_t OFF_O = OFF_KT + 2048ull * 8448 * 2;
constexpr size_t OFF_ST = OFF_O + 3ull * 8448 * OLD * 2;
constexpr size_t OFF_ATT = OFF_ST + 256ull * 65536 * 2;
constexpr size_t OFF_OC = OFF_ATT + 132ull * 65536 * 2;
constexpr size_t OFF_GC = OFF_OC + 3ull * 1024 * OLD * 2;
constexpr size_t WS_NEED = OFF_GC + 1024ull * 3072 * 2;
static_assert(132ull * 131072 <= 8448ull * HLD * 2 && 132ull * 131072 <= 8448ull * OLD * 2, "diff scratch overlay");
static_assert(8448ull * ULD * 2 <= 8448ull * ZLD * 2, "U overlay");

struct P {
    const float *x, *c, *ctx, *c_ctx, *w_mod, *b_mod, *w_in, *dec_f, *dec_b, *lq1, *lk1, *lq2, *lk2, *subln_g, *rpb,
        *w_pa, *w_pb, *w_pc, *w_o, *ln1_g, *ln1_b, *w_ff1, *w_ff2, *ln2_g, *ln2_b;
    float* out;
    char* ws;
};

DI int tid() { int t = threadIdx.x; asm volatile("" : "+v"(t)); return t; }
DI char* launder(char* q) { size_t off = 0; asm volatile("" : "+s"(off)); return q + off; }
typedef float f32x2_ __attribute__((ext_vector_type(2)));
typedef __bf16 bf16x2_ __attribute__((ext_vector_type(2)));
DI unsigned pack2(float lo, float hi) { f32x2_ v = {lo, hi}; bf16x2_ b = __builtin_convertvector(v, bf16x2_); return __builtin_bit_cast(unsigned, b); }
DI unsigned short f2bf(float x) { return (unsigned short)(pack2(x, 0.f) & 0xffffu); }
DI float wave_sum(float v) { for (int o = 32; o > 0; o >>= 1) v += __shfl_xor(v, o); return v; }
DI float sigmoidf_(float x) { return 1.f / (1.f + __expf(-x)); }
template <int MI>
DI void zero4(f32x16 (&a)[MI][2]) {
#pragma unroll
    for (int i = 0; i < MI; ++i)
#pragma unroll
        for (int j = 0; j < 2; ++j)
#pragma unroll
            for (int e = 0; e < 16; ++e) a[i][j][e] = 0.f;
}

#define XB_TMO      128
#define XB_XCNT(j)  (256  + 64 * (j))
#define XB_XSUB(j)  (1280 + 64 * (j))
#define XB_XGEN(j)  (2304 + 64 * (j))
#define XB_TOP      3328
#define XB_TOPGEN   3392
#define XCD_BAR_WORDS 3456
#define XB_SPIN_CAP (1u << 23)
DI unsigned xb_ld(unsigned* p) { return __hip_atomic_load(p, __ATOMIC_RELAXED, __HIP_MEMORY_SCOPE_AGENT); }
DI unsigned xb_add(unsigned* p, unsigned v) { return __hip_atomic_fetch_add(p, v, __ATOMIC_RELAXED, __HIP_MEMORY_SCOPE_AGENT); }
DI unsigned xb_xcc_id() { return (unsigned)__builtin_amdgcn_s_getreg((3 << 11) | 20) & 0xFu; }
#define XB_SPIN(cond, bar) do { unsigned _sp = 0; while (cond) { __builtin_amdgcn_s_sleep(1); \
    if ((++_sp & 255u) == 0u) { if (xb_ld(&(bar)[XB_TMO])) break; if (_sp > XB_SPIN_CAP) { atomicAdd(&(bar)[XB_TMO], 1u); break; } } } } while (0)
struct XcdBarrier { unsigned* bar; unsigned x; volatile LAS unsigned* st; };
DI XcdBarrier xcd_barrier_post(unsigned* bar, volatile LAS unsigned* st) {
    XcdBarrier b; b.bar = bar; b.x = xb_xcc_id(); b.st = st;
    if (threadIdx.x == 0) (void)xb_add(&bar[XB_XCNT(b.x)], 1u);
    return b;
}
DI void xcd_barrier_complete(unsigned* bar, unsigned x, unsigned& nloc, unsigned& nx) {
    const unsigned G = gridDim.x * gridDim.y * gridDim.z;
    unsigned sum, cnt, mine, sp = 0u;
    for (;;) {
        sum = 0u; cnt = 0u; mine = 0u;
#pragma unroll
        for (unsigned j = 0; j < 16; ++j) { const unsigned c = xb_ld(&bar[XB_XCNT(j)]); sum += c; cnt += (c > 0u) ? 1u : 0u; mine = (j == x) ? c : mine; }
        if (sum == G) break;
        __builtin_amdgcn_s_sleep(1);
        if ((++sp & 255u) == 0u) { if (xb_ld(&bar[XB_TMO])) break; if (sp > XB_SPIN_CAP) { atomicAdd(&bar[XB_TMO], 1u); break; } }
    }
    nloc = mine > 0u ? mine : 1u; nx = cnt > 0u ? cnt : 1u;
}
DI void xcd_barrier(const XcdBarrier& b) {
    asm volatile("s_waitcnt vmcnt(0)" ::: "memory");
    __syncthreads();
    if (threadIdx.x == 0) {
        unsigned* bar = (unsigned*)launder((char*)b.bar);
        __builtin_amdgcn_s_waitcnt(0);
        unsigned nloc = b.st[0], nx = b.st[1];
        if (nloc == 0u) { xcd_barrier_complete(bar, b.x, nloc, nx); b.st[0] = nloc; b.st[1] = nx; }
        const unsigned old = xb_add(&bar[XB_XSUB(b.x)], 1u);
        const unsigned gen = old / nloc;
        if (old + 1u == (gen + 1u) * nloc) {
            __builtin_amdgcn_fence(__ATOMIC_RELEASE, "agent");
            asm volatile("s_waitcnt vmcnt(0)" ::: "memory");
            const unsigned og = xb_add(&bar[XB_TOP], 1u);
            const unsigned tg = og / nx;
            if (og + 1u == (tg + 1u) * nx) xb_add(&bar[XB_TOPGEN], 1u);
            else XB_SPIN(xb_ld(&bar[XB_TOPGEN]) == tg, bar);
            __builtin_amdgcn_fence(__ATOMIC_ACQUIRE, "agent");
            xb_add(&bar[XB_XGEN(b.x)], 1u);
            asm volatile("s_waitcnt vmcnt(0)" ::: "memory");
        } else {
            XB_SPIN(xb_ld(&bar[XB_XGEN(b.x)]) == gen, bar);
            __builtin_amdgcn_fence(__ATOMIC_ACQUIRE, "agent");
            asm volatile("s_waitcnt vmcnt(0)" ::: "memory");
        }
    }
    __syncthreads();
}

template <bool SWAP, int MI = 4>
DI void gemm_kloop(const bf16_t* __restrict__ A, int lda, const bf16_t* __restrict__ B, int ldb, int K, f32x16 (&acc)[MI][2], char* smem) {
    const int tid_ = tid();
    const int t = tid_, r = t >> 3, c = (t & 7) * 8;
    const int w = t >> 6, l = t & 63, lr = l & 31, lh = l >> 5, wm = w >> 2, wn = w & 3;
    const bf16_t* pa = A + (size_t)r * lda + c;
    const bf16_t* pb = B + (size_t)r * ldb + c;
    u32x4 ra[MI], rb[4];
    const int nk = K >> 6;
    __syncthreads();
    {
        bf16_t(*sa_)[72] = (bf16_t(*)[72])smem; bf16_t(*sb_)[72] = (bf16_t(*)[72])(smem + 36864);
#pragma unroll
        for (int i = 0; i < MI; ++i) ra[i] = *(const u32x4*)(pa + (size_t)(64 * i) * lda);
#pragma unroll
        for (int i = 0; i < 4; ++i) rb[i] = *(const u32x4*)(pb + (size_t)(64 * i) * ldb);
#pragma unroll
        for (int i = 0; i < MI; ++i) *(u32x4*)&sa_[r + 64 * i][c] = ra[i];
#pragma unroll
        for (int i = 0; i < 4; ++i) *(u32x4*)&sb_[r + 64 * i][c] = rb[i];
        if (nk > 1) {
#pragma unroll
            for (int i = 0; i < MI; ++i) ra[i] = *(const u32x4*)(pa + (size_t)(64 * i) * lda + 64);
#pragma unroll
            for (int i = 0; i < 4; ++i) rb[i] = *(const u32x4*)(pb + (size_t)(64 * i) * ldb + 64);
        }
    }
    __syncthreads();
    for (int kt = 0; kt < nk; ++kt) {
        const bf16_t(*sa)[72] = (const bf16_t(*)[72])(smem + (kt & 1) * 73728);
        const bf16_t(*sb)[72] = (const bf16_t(*)[72])(smem + (kt & 1) * 73728 + 36864);
        bf16_t(*sa_)[72] = (bf16_t(*)[72])(smem + ((kt + 1) & 1) * 73728);
        bf16_t(*sb_)[72] = (bf16_t(*)[72])(smem + ((kt + 1) & 1) * 73728 + 36864);
        const bool st = kt + 1 < nk, ld = kt + 2 < nk;
        const int k2 = (kt + 2) * 64;
        constexpr int NF = (MI <= 2 || PIPE4) ? 2 : 1;
        bf16x8 fa[NF][MI], fb[NF][2];
        if (NF == 2) {
#pragma unroll
            for (int i = 0; i < MI; ++i) fa[0][i] = *(const bf16x8*)&sa[32 * MI * wm + 32 * i + lr][8 * lh];
#pragma unroll
            for (int j = 0; j < 2; ++j) fb[0][j] = *(const bf16x8*)&sb[64 * wn + 32 * j + lr][8 * lh];
        }
#pragma unroll
        for (int s = 0; s < 4; ++s) {
            const int cur = (NF == 2) ? (s & 1) : 0, nxt = (NF == 2) ? ((s + 1) & 1) : 0, sr = (NF == 2) ? s + 1 : s;
            if (NF == 1 || s < 3) {
#pragma unroll
                for (int i = 0; i < MI; ++i) fa[nxt][i] = *(const bf16x8*)&sa[32 * MI * wm + 32 * i + lr][16 * sr + 8 * lh];
#pragma unroll
                for (int j = 0; j < 2; ++j) fb[nxt][j] = *(const bf16x8*)&sb[64 * wn + 32 * j + lr][16 * sr + 8 * lh];
            }
#pragma unroll
            for (int i = 0; i < MI; ++i)
#pragma unroll
                for (int j = 0; j < 2; ++j) acc[i][j] = SWAP ? MFMA(fb[cur][j], fa[cur][i], acc[i][j]) : MFMA(fa[cur][i], fb[cur][j], acc[i][j]);
            if (s < MI) {
                if (st) *(u32x4*)&sa_[r + 64 * s][c] = ra[s];
                if (ld) ra[s] = *(const u32x4*)(pa + (size_t)(64 * s) * lda + k2);
            }
            if (st) *(u32x4*)&sb_[r + 64 * s][c] = rb[s];
            if (ld) rb[s] = *(const u32x4*)(pb + (size_t)(64 * s) * ldb + k2);
            __builtin_amdgcn_sched_barrier(0);
        }
        __syncthreads();
    }
}

template <int MI>
DI void store_swap_bf16(const f32x16 (&acc)[MI][2], bf16_t* C, int ldc, int m0, int n0) {
    const int tid_ = tid();
    const int t = tid_, w = t >> 6, l = t & 63, lr = l & 31, lh = l >> 5, wm = w >> 2, wn = w & 3;
#pragma unroll
    for (int i = 0; i < MI; ++i)
#pragma unroll
        for (int j = 0; j < 2; ++j) {
            const int m = m0 + 32 * MI * wm + 32 * i + lr, nb = n0 + 64 * wn + 32 * j + 4 * lh;
#pragma unroll
            for (int q = 0; q < 4; ++q) {
                uint2 v; v.x = pack2(acc[i][j][4 * q], acc[i][j][4 * q + 1]); v.y = pack2(acc[i][j][4 * q + 2], acc[i][j][4 * q + 3]);
                *(uint2*)(C + (size_t)m * ldc + nb + 8 * q) = v;
            }
        }
}
template <int MI>
DI void store_swap_f32(const f32x16 (&acc)[MI][2], float* C, int ldc, int m0, int n0) {
    const int tid_ = tid();
    const int t = tid_, w = t >> 6, l = t & 63, lr = l & 31, lh = l >> 5, wm = w >> 2, wn = w & 3;
#pragma unroll
    for (int i = 0; i < MI; ++i)
#pragma unroll
        for (int j = 0; j < 2; ++j) {
            const int m = m0 + 32 * MI * wm + 32 * i + lr, nb = n0 + 64 * wn + 32 * j + 4 * lh;
#pragma unroll
            for (int q = 0; q < 4; ++q) {
                float4 v = make_float4(acc[i][j][4 * q], acc[i][j][4 * q + 1], acc[i][j][4 * q + 2], acc[i][j][4 * q + 3]);
                *(float4*)(C + (size_t)m * ldc + nb + 8 * q) = v;
            }
        }
}

DI int ret_perm(int c) { const int G = c >> 4, w = c & 15; return (w < 8) ? (8 * G + w) : (128 + 8 * G + (w - 8)); }
DI int diff_perm(int c) { const int G = c >> 4, w = c & 15, axis = G >> 1, j = 8 * (G & 1) + (w & 7); return 32 * axis + ((w < 8) ? 0 : 16) + j; }
DI int inproj_src(int n) {
    const int g = n >> 10, c = n & 1023;
    switch (g) {
        case 0: return 0 + (c & ~255) + ret_perm(c & 255);
        case 1: return 1024 + (c & ~255) + ret_perm(c & 255);
        case 2: return 3072 + c;
        case 3: return 4096 + (c & ~63) + diff_perm(c & 63);
        case 4: return 5120 + (c & ~63) + diff_perm(c & 63);
        case 5: return 7168 + c;
        case 6: return 8192 + c;
        case 7: return 10240 + c;
        case 8: return 11264 + c;
        case 9: return 12288 + c;
        case 10: return 2048 + c;
        case 11: return 6144 + c;
        default: return 9216 + c;
    }
}
DI void convert_tile(const float* __restrict__ src, int Nsrc, bf16_t* __restrict__ dst, int dld, int n0, int k0, bool inmap, char* smem) {
    const int tid_ = tid();
    float* tl = (float*)smem;
    const int t = tid_, tx = t & 63, ty = t >> 6;
    const int ncol = inmap ? inproj_src(n0 + tx) : (n0 + tx);
    __syncthreads();
#pragma unroll 4
    for (int i = 0; i < 8; ++i) { const int ky = ty + 8 * i; tl[ky * 65 + tx] = src[(size_t)(k0 + ky) * Nsrc + ncol]; }
    __syncthreads();
#pragma unroll 4
    for (int i = 0; i < 8; ++i) { const int ny = ty + 8 * i; dst[(size_t)(n0 + ny) * dld + k0 + tx] = f2bf(tl[tx * 65 + ny]); }
}
DI void phase_convert(const P& p, int l, char* smem) {
    char* ws_ = launder(p.ws);
    for (int idx = blockIdx.x; idx < 6400; idx += gridDim.x) {
        if (idx < 3328) {
            convert_tile(p.w_in + (size_t)l * 1024 * INW, INW, (bf16_t*)(ws_ + OFF_WIN), WK, (idx >> 4) * 64, (idx & 15) * 64, true, smem);
        } else if (idx < 4352) {
            const int j = idx - 3328, m = j >> 8, tt = j & 255;
            const float* src = (m == 0 ? p.w_pa : m == 1 ? p.w_pb : m == 2 ? p.w_pc : p.w_o) + (size_t)l * 1024 * 1024;
            bf16_t* dst = (bf16_t*)(ws_ + (m < 3 ? OFF_WP + (size_t)m * 1024 * WK * 2 : OFF_WO));
            convert_tile(src, 1024, dst, WK, (tt >> 4) * 64, (tt & 15) * 64, false, smem);
        } else if (idx < 5376) {
            const int j = idx - 4352;
            convert_tile(p.w_ff1 + (size_t)l * 1024 * DFF, DFF, (bf16_t*)(ws_ + OFF_WF1), WK, (j >> 4) * 64, (j & 15) * 64, false, smem);
        } else {
            const int j = idx - 5376;
            convert_tile(p.w_ff2 + (size_t)l * DFF * 1024, 1024, (bf16_t*)(ws_ + OFF_WF2), WK2, (j >> 6) * 64, (j & 63) * 64, false, smem);
        }
    }
}

DI void sincos_tab(float ang, float& c, float& s) {
    const double x = (double)ang;
    const double n = rint(x * 0.63661977236758134308);
    double r = fma(-n, 1.57079632673412561417e+00, x);
    r = fma(-n, 6.07710050650619224932e-11, r);
    const double r2 = r * r;
    double sp = 1.0 / 6227020800.0;
    sp = fma(sp, r2, -1.0 / 39916800.0); sp = fma(sp, r2, 1.0 / 362880.0); sp = fma(sp, r2, -1.0 / 5040.0);
    sp = fma(sp, r2, 1.0 / 120.0); sp = fma(sp, r2, -1.0 / 6.0); sp = fma(sp, r2, 1.0);
    const double sr = sp * r;
    double cp = -1.0 / 87178291200.0;
    cp = fma(cp, r2, 1.0 / 479001600.0); cp = fma(cp, r2, -1.0 / 3628800.0); cp = fma(cp, r2, 1.0 / 40320.0);
    cp = fma(cp, r2, -1.0 / 720.0); cp = fma(cp, r2, 1.0 / 24.0); cp = fma(cp, r2, -0.5); cp = fma(cp, r2, 1.0);
    const int q = ((int)n) & 3;
    const double ss = (q == 0) ? sr : (q == 1) ? cp : (q == 2) ? -sr : -cp;
    const double cc = (q == 0) ? cp : (q == 1) ? -sr : (q == 2) ? -cp : sr;
    c = (float)cc; s = (float)ss;
}
DI void phase_tables(const P& p) {
    const int tid_ = tid();
    char* ws_ = launder(p.ws);
    float2* tab = (float2*)(ws_ + OFF_TAB);
    const int total = 160 * 8192;
    for (int idx = blockIdx.x * 512 + tid_; idx < total; idx += gridDim.x * 512) {
        const int row = idx >> 13, t = idx & 8191;
        float inv, pos;
        if (row < 128) { const float frac = (float)row / 127.0f; inv = (float)exp(-9.210340371976184 * (double)frac); pos = (float)t; }
        else { const int j = (row - 128) & 15; inv = (float)exp(-9.210340371976184 * ((double)j / 16.0)); pos = (row < 144) ? (float)(t >> 6) : (float)(t & 63); }
        const float ang = pos * inv;
        float c, s; sincos_tab(ang, c, s);
        tab[idx] = make_float2(c, s);
    }
}
DI void phase_misc(const P& p) {
    const int tid_ = tid();
    char* ws_ = launder(p.ws);
    if (blockIdx.x == 0) {
        float* misc = (float*)(ws_ + OFF_MISC);
        const int t = tid_;
        if (t < 16) {
            const int l = t >> 3, dir = (t >> 2) & 1, h = t & 3;
            const double xx = (double)(dir ? p.dec_b : p.dec_f)[l * 4 + h];
            const double lg = (xx > 0.0) ? -log1p(exp(-xx)) : (xx - log1p(exp(xx)));
            misc[8 + l * 8 + dir * 4 + h] = (float)(lg * 1.4426950408889634);
        } else if (t < 18) {
            const int l = t - 16;
            float s1 = 0.f, s2 = 0.f;
            for (int i = 0; i < 64; ++i) { s1 += p.lq1[l * 64 + i] * p.lk1[l * 64 + i]; s2 += p.lq2[l * 64 + i] * p.lk2[l * 64 + i]; }
            const float lam_init = 0.8f - 0.6f * expf(-0.3f * (float)l);
            misc[l] = expf(s1) - expf(s2) + lam_init;
        }
    }
}
DI void phase_mod(const P& p, char* smem) {
    const int tid_ = tid();
    char* ws_ = launder(p.ws);
    float* sc = (float*)smem;
    float* red = (float*)(smem + 20480);
    float* mod = (float*)(ws_ + OFF_MOD);
    const int t = tid_, nn = t & 63, kg = t >> 6;
    for (int idx = blockIdx.x; idx < 192; idx += gridDim.x) {
        const int l = idx / 96, nc = idx % 96, n = nc * 64 + nn;
        __syncthreads();
        for (int i = t; i < 5120; i += 512) { const int r = i >> 10, k = i & 1023; const float v = (r < 4) ? p.c[r * 1024 + k] : p.c_ctx[k]; sc[i] = v * sigmoidf_(v); }
        __syncthreads();
        float a[5] = {0.f, 0.f, 0.f, 0.f, 0.f};
        const float* wp = p.w_mod + (size_t)l * 1024 * 6144 + n;
        for (int k = kg; k < 1024; k += 8) {
            const float wv = wp[(size_t)k * 6144];
#pragma unroll
            for (int r = 0; r < 5; ++r) a[r] += sc[r * 1024 + k] * wv;
        }
#pragma unroll
        for (int r = 0; r < 5; ++r) red[(kg * 5 + r) * 64 + nn] = a[r];
        __syncthreads();
        if (kg == 0) {
#pragma unroll
            for (int r = 0; r < 5; ++r) {
                float s = 0.f;
                for (int g8 = 0; g8 < 8; ++g8) s += red[(g8 * 5 + r) * 64 + nn];
                mod[((size_t)l * 5 + r) * 6144 + n] = s + p.b_mod[l * 6144 + n];
            }
        }
    }
}

DI void ln_stats(const float (&v)[16], float& mean, float& rstd, float eps) {
    float s = 0.f;
#pragma unroll
    for (int i = 0; i < 16; ++i) s += v[i];
    s = wave_sum(s); mean = s * (1.f / 1024.f);
    float q = 0.f;
#pragma unroll
    for (int i = 0; i < 16; ++i) { const float d = v[i] - mean; q += d * d; }
    q = wave_sum(q); rstd = rsqrtf(q * (1.f / 1024.f) + eps);
}
DI void load16(const float* p, int lane, float (&v)[16]) {
#pragma unroll
    for (int i = 0; i < 4; ++i) { const float4 a = *(const float4*)(p + 4 * (lane + 64 * i)); v[4 * i] = a.x; v[4 * i + 1] = a.y; v[4 * i + 2] = a.z; v[4 * i + 3] = a.w; }
}
DI void store16(float* p, int lane, const float (&v)[16]) {
#pragma unroll
    for (int i = 0; i < 4; ++i) *(float4*)(p + 4 * (lane + 64 * i)) = make_float4(v[4 * i], v[4 * i + 1], v[4 * i + 2], v[4 * i + 3]);
}
DI void store16_bf(bf16_t* p, int lane, const float (&v)[16]) {
#pragma unroll
    for (int i = 0; i < 4; ++i) { uint2 u; u.x = pack2(v[4 * i], v[4 * i + 1]); u.y = pack2(v[4 * i + 2], v[4 * i + 3]); *(uint2*)(p + 4 * (lane + 64 * i)) = u; }
}
DI const float* in_row(const P& p, int b, int r) { return (r < SEQ) ? p.x + ((size_t)b * SEQ + r) * D : p.ctx + ((size_t)b * CTXL + (r - SEQ)) * D; }
DI float* xs_row(const P& p, int b, int r) { return (r < SEQ) ? p.out + ((size_t)b * SEQ + r) * D : (float*)(p.ws + OFF_XC) + ((size_t)b * CTXL + (r - SEQ)) * D; }

DI void phase_lnmod0(const P& p) {
    const int tid_ = tid();
    char* ws_ = launder(p.ws);
    const int lane = tid_ & 63, wv = tid_ >> 6;
    const float* mod = (const float*)(ws_ + OFF_MOD);
    bf16_t* H = (bf16_t*)(ws_ + OFF_H);
    for (int row = blockIdx.x * 8 + wv; row < NBATCH * RB; row += gridDim.x * 8) {
        const int b = row / RB, r = row % RB, mi = (r < SEQ) ? b : 4;
        float v[16], sh[16], sc[16]; load16(in_row(p, b, r), lane, v);
        float mean, rstd; ln_stats(v, mean, rstd, 1e-6f);
        load16(mod + (size_t)mi * 6144 + 0 * 1024, lane, sh); load16(mod + (size_t)mi * 6144 + 1 * 1024, lane, sc);
#pragma unroll
        for (int i = 0; i < 16; ++i) v[i] = (v[i] - mean) * rstd * (1.f + sc[i]) + sh[i];
        store16_bf(H + (size_t)row * HLD, lane, v);
    }
}
DI void phase_ln1(const P& p, int l, int b, int nrows, int cmode) {
    const int tid_ = tid();
    char* ws_ = launder(p.ws);
    const int lane = tid_ & 63, wv = tid_ >> 6;
    const float* mod = (const float*)(ws_ + OFF_MOD) + (size_t)l * 5 * 6144;
    const float* Y = (const float*)(ws_ + OFF_ST);
    bf16_t* H = (bf16_t*)(ws_ + OFF_H);
    const float alpha = 1.4142135623730951f;
    for (int r = blockIdx.x * 8 + wv; r < nrows; r += gridDim.x * 8) {
        const int bb = cmode ? (r >> 8) : b, rr = cmode ? SEQ + (r & 255) : r;
        const int mi = (rr < SEQ) ? bb : 4;
        float v[16], y[16], g[16], lg[16], lb[16], sh[16], sc[16];
        load16(l == 0 ? in_row(p, bb, rr) : xs_row(p, bb, rr), lane, v);
        load16(Y + (size_t)r * D, lane, y); load16(mod + (size_t)mi * 6144 + 2 * 1024, lane, g);
        load16(p.ln1_g + l * 1024, lane, lg); load16(p.ln1_b + l * 1024, lane, lb);
        load16(mod + (size_t)mi * 6144 + 3 * 1024, lane, sh); load16(mod + (size_t)mi * 6144 + 4 * 1024, lane, sc);
#pragma unroll
        for (int i = 0; i < 16; ++i) v[i] = alpha * v[i] + g[i] * y[i];
        float mean, rstd; ln_stats(v, mean, rstd, 1e-6f);
#pragma unroll
        for (int i = 0; i < 16; ++i) v[i] = (v[i] - mean) * rstd * lg[i] + lb[i];
        store16(xs_row(p, bb, rr), lane, v);
        ln_stats(v, mean, rstd, 1e-6f);
#pragma unroll
        for (int i = 0; i < 16; ++i) v[i] = (v[i] - mean) * rstd * (1.f + sc[i]) + sh[i];
        store16_bf(cmode ? (bf16_t*)(ws_ + OFF_KT + (4u << 20)) + (size_t)r * HLD : H + ((size_t)b * RB + r) * HLD, lane, v);
    }
}
DI void phase_ln2(const P& p, int l, int b, int nrows, int cmode) {
    const int tid_ = tid();
    char* ws_ = launder(p.ws);
    const int lane = tid_ & 63, wv = tid_ >> 6;
    const float* mod = (const float*)(ws_ + OFF_MOD) + (size_t)l * 5 * 6144;
    const float* modn = (const float*)(ws_ + OFF_MOD) + (size_t)1 * 5 * 6144;
    const float* Y2 = (const float*)(ws_ + OFF_ST);
    bf16_t* H = (bf16_t*)(ws_ + OFF_H);
    const float alpha = 1.4142135623730951f;
    for (int r = blockIdx.x * 8 + wv; r < nrows; r += gridDim.x * 8) {
        const int bb = cmode ? (r >> 8) : b, rr = cmode ? SEQ + (r & 255) : r;
        const int mi = (rr < SEQ) ? bb : 4;
        float v[16], y[16], g[16], lg[16], lb[16], sh[16], sc[16];
        load16(xs_row(p, bb, rr), lane, v);
        load16(Y2 + (size_t)r * D, lane, y); load16(mod + (size_t)mi * 6144 + 5 * 1024, lane, g);
        load16(p.ln2_g + l * 1024, lane, lg); load16(p.ln2_b + l * 1024, lane, lb);
        if (l == 0) { load16(modn + (size_t)mi * 6144 + 0 * 1024, lane, sh); load16(modn + (size_t)mi * 6144 + 1 * 1024, lane, sc); }
#pragma unroll
        for (int i = 0; i < 16; ++i) v[i] = alpha * v[i] + g[i] * y[i];
        float mean, rstd; ln_stats(v, mean, rstd, 1e-6f);
#pragma unroll
        for (int i = 0; i < 16; ++i) v[i] = (v[i] - mean) * rstd * lg[i] + lb[i];
        store16(xs_row(p, bb, rr), lane, v);
        if (l == 0) {
            ln_stats(v, mean, rstd, 1e-6f);
#pragma unroll
            for (int i = 0; i < 16; ++i) v[i] = (v[i] - mean) * rstd * (1.f + sc[i]) + sh[i];
            store16_bf(H + ((size_t)bb * RB + rr) * HLD, lane, v);
        }
    }
}

DI void phase_inproj(const P& p, int l, int b, char* smem) {
    const int tid_ = tid();
    char* ws_ = launder(p.ws);
    const bf16_t* Hb = (const bf16_t*)(ws_ + OFF_H) + (size_t)b * RB * HLD;
    const bf16_t* W = (const bf16_t*)(ws_ + OFF_WIN);
    bf16_t* Z = (bf16_t*)(ws_ + OFF_Z);
    bf16_t* VT = (bf16_t*)(ws_ + OFF_VT);
    bf16_t* KT = (bf16_t*)(ws_ + OFF_KT);
    const float2* tab = (const float2*)(ws_ + OFF_TAB);
    const float* misc = (const float*)(ws_ + OFF_MISC);
    const int t = tid_, w = t >> 6, ln = t & 63, lr = ln & 31, lh = ln >> 5, wm = w >> 2, wn = w & 3;
    const int NTN = INW / 256, NTM = RB / 256;
    for (int idx = blockIdx.x; idx < NTM * NTN; idx += gridDim.x) {
        const int tn = idx % NTN, tm = idx / NTN, m0 = tm * 256, n0 = tn * 256, grp = n0 >> 10;
        f32x16 acc[4][2]; zero4(acc);
        if (grp >= 10) {
            gemm_kloop<false>(Hb + (size_t)m0 * HLD, HLD, W + (size_t)n0 * WK, WK, D, acc, smem);
#pragma unroll
            for (int i = 0; i < 4; ++i)
#pragma unroll
                for (int j = 0; j < 2; ++j) {
                    const int n = n0 + 64 * wn + 32 * j + lr, mb = m0 + 128 * wm + 32 * i + 4 * lh;
                    bf16_t* dst = VT + (size_t)(n - 10240) * VLD + mb;
#pragma unroll
                    for (int q = 0; q < 4; ++q) {
                        uint2 v; v.x = pack2(acc[i][j][4 * q], acc[i][j][4 * q + 1]); v.y = pack2(acc[i][j][4 * q + 2], acc[i][j][4 * q + 3]);
                        *(uint2*)(dst + 8 * q) = v;
                    }
                }
        } else {
            gemm_kloop<true>(Hb + (size_t)m0 * HLD, HLD, W + (size_t)n0 * WK, WK, D, acc, smem);
#pragma unroll
            for (int i = 0; i < 4; ++i) {
                const int m = m0 + 128 * wm + 32 * i + lr;
                const bool lat = m < SEQ;
#pragma unroll
                for (int j = 0; j < 2; ++j) {
                    const int nb = n0 + 64 * wn + 32 * j;
                    f32x16& a = acc[i][j];
                    if (grp == 0 || grp == 1 || grp == 3 || grp == 4) {
                        if (lat) {
#pragma unroll
                            for (int g2 = 0; g2 < 2; ++g2)
#pragma unroll
                                for (int e = 0; e < 4; ++e) {
                                    int trow;
                                    if (grp < 2) { const int G = ((nb & 255) >> 4) + g2; trow = 8 * G + e + 4 * lh; }
                                    else { const int G = ((nb & 63) >> 4) + g2; trow = 128 + 16 * (G >> 1) + 8 * (G & 1) + e + 4 * lh; }
                                    const float2 cs = tab[(size_t)trow * 8192 + m];
                                    const float x1 = a[8 * g2 + e], x2 = a[8 * g2 + e + 4];
                                    a[8 * g2 + e] = x1 * cs.x - x2 * cs.y;
                                    a[8 * g2 + e + 4] = x1 * cs.y + x2 * cs.x;
                                }
                        }
                        const float sc = (grp == 1) ? 0.0625f : (grp == 3) ? 0.125f * L2E : 1.f;
#pragma unroll
                        for (int e = 0; e < 16; ++e) a[e] *= sc;
                    } else if (grp == 5) {
#pragma unroll
                        for (int e = 0; e < 16; ++e) a[e] *= 0.125f * L2E;
                    } else if (grp >= 7) {
#pragma unroll
                        for (int e = 0; e < 16; ++e) a[e] = sigmoidf_(a[e]);
                    }
                    bf16_t* dst = Z + (size_t)m * ZLD + nb + 4 * lh;
#pragma unroll
                    for (int q = 0; q < 4; ++q) {
                        uint2 v; v.x = pack2(a[4 * q], a[4 * q + 1]); v.y = pack2(a[4 * q + 2], a[4 * q + 3]);
                        *(uint2*)(dst + 8 * q) = v;
                    }
                    if (grp == 1) {
                        const int h4 = (nb - 1024) >> 8;
                        const int ic = (lat ? m : m - SEQ) & 255;
                        const float df = exp2f(misc[8 + l * 8 + 0 + h4] * (float)(255 - ic));
                        const float db = exp2f(misc[8 + l * 8 + 4 + h4] * (float)ic);
#pragma unroll
                        for (int e = 0; e < 16; ++e) {
                            const int n = nb + (e & 3) + 8 * (e >> 2) + 4 * lh - 1024;
                            KT[(size_t)n * VLD + m] = f2bf(a[e] * df);
                            KT[(size_t)(1024 + n) * VLD + m] = f2bf(a[e] * db);
                        }
                    }
                }
            }
        }
    }
}

struct NoMask {
    DI bool active(int) const { return true; }
    DI void apply(int, f32x16 (&)[2], int) const {}
};
struct NaMask {
    int r, rs, j, cs; const float* rpb;
    DI bool active(int kt) const { return kt >= 128 || (kt >= rs && kt < rs + 8); }
    DI void apply(int kt, f32x16 (&st)[2], int lh) const {
        if (kt < 128) {
            const float* bl = rpb + (kt - r + 7) * 31 + (4 * lh - j + 15);
            const int c0 = 4 * lh - cs;
#pragma unroll
            for (int kk = 0; kk < 2; ++kk)
#pragma unroll
                for (int e = 0; e < 16; ++e) {
                    const int kce = 32 * kk + (e & 3) + 8 * (e >> 2);
                    const bool ok = (unsigned)(kce + c0) < 16u;
                    st[kk][e] = ok ? st[kk][e] + bl[kce] : -1e30f;
                }
        }
    }
};
template <int DV, class MaskF>
DI void flash_core(const bf16_t* __restrict__ zq, const bf16_t* __restrict__ zk, const bf16_t* __restrict__ vt,
                   int t1s, int t1n, int t2s, int t2n, const MaskF& mf, f32x16 (&ot)[DV / 32], char* smem) {
    const int tid_ = tid();
    constexpr int ND = DV / 32;
    const int t = tid_, w = t >> 6, l = t & 63, lr = l & 31, lh = l >> 5;
    bf16_t(*sq)[72] = (bf16_t(*)[72])(smem + 57344);
#pragma unroll
    for (int d = 0; d < ND; ++d)
#pragma unroll
        for (int e = 0; e < 16; ++e) ot[d][e] = 0.f;
    float mrun = 0.f, lrun = 0.f;
#if FOLD_M
    bf16x8 kone, qm;
    { union { bf16x8 v; unsigned u[4]; } kk_; kk_.u[0] = (lh == 0) ? 0x3f80u : 0u; kk_.u[1] = 0u; kk_.u[2] = 0u; kk_.u[3] = 0u; kone = kk_.v; kk_.u[0] = 0u; qm = kk_.v; }
#endif
    const int nt = t1n + t2n;
    const int crow_ = t >> 3, cc = t & 7;
    const int plo = 16 * (cc >> 1) + 4 * (cc & 1);
    constexpr int NV = DV / 64;
    u32x4 kreg, vreg[NV];
#define FC_TILE(IT) (((IT) < t1n) ? (t1s + (IT)) : (t2s + (IT) - t1n))
#define FC_PREFETCH(KT) do { const int kt_ = (KT); \
        kreg = *(const u32x4*)(zk + (size_t)(64 * kt_ + crow_) * ZLD + cc * 8); \
        _Pragma("unroll") for (int i = 0; i < NV; ++i) vreg[i] = *(const u32x4*)(vt + (size_t)(crow_ + 64 * i) * VLD + 64 * kt_ + cc * 8); } while (0)
#define FC_STORE(BUF) do { bf16_t(*sk_)[72] = (bf16_t(*)[72])(smem + (BUF) * 27648); bf16_t(*sv_)[72] = (bf16_t(*)[72])(smem + (BUF) * 27648 + 64 * 144); \
        *(u32x4*)&sk_[crow_][cc * 8] = kreg; \
        _Pragma("unroll") for (int i = 0; i < NV; ++i) { u32x2 lo_, hi_; lo_.x = vreg[i].x; lo_.y = vreg[i].y; hi_.x = vreg[i].z; hi_.y = vreg[i].w; \
            *(u32x2*)&sv_[crow_ + 64 * i][plo] = lo_; *(u32x2*)&sv_[crow_ + 64 * i][plo + 8] = hi_; } } while (0)
    __syncthreads();
    {
#pragma unroll
        for (int i = 0; i < 4; ++i) { const u32x4 qv = *(const u32x4*)(zq + (size_t)(crow_ + 64 * i) * ZLD + cc * 8); *(u32x4*)&sq[crow_ + 64 * i][cc * 8] = qv; }
    }
    FC_PREFETCH(FC_TILE(0));
    FC_STORE(0);
    if (nt > 1) FC_PREFETCH(FC_TILE(1));
    __syncthreads();
    for (int it = 0; it < nt; ++it) {
        const int kt = FC_TILE(it);
        if (it + 1 < nt) FC_STORE((it + 1) & 1);
        if (it + 2 < nt) FC_PREFETCH(FC_TILE(it + 2));
        if (mf.active(kt)) {
            const bf16_t(*sk)[72] = (const bf16_t(*)[72])(smem + (it & 1) * 27648);
            const bf16_t(*sv)[72] = (const bf16_t(*)[72])(smem + (it & 1) * 27648 + 64 * 144);
            f32x16 st[2];
#pragma unroll
            for (int kk = 0; kk < 2; ++kk)
#pragma unroll
                for (int e = 0; e < 16; ++e) st[kk][e] = 0.f;
#pragma unroll
            for (int s = 0; s < 4; ++s) {
                const bf16x8 qfs = *(const bf16x8*)&sq[32 * w + lr][16 * s + 8 * lh];
#pragma unroll
                for (int kk = 0; kk < 2; ++kk) {
                    const bf16x8 kf = *(const bf16x8*)&sk[32 * kk + lr][16 * s + 8 * lh];
                    st[kk] = MFMA(kf, qfs, st[kk]);
                }
            }
#if FOLD_M
#pragma unroll
            for (int kk = 0; kk < 2; ++kk) st[kk] = MFMA(kone, qm, st[kk]);
#endif
            mf.apply(kt, st, lh);
            union { bf16x8 v; unsigned u[4]; } pf[4];
            float ps = 0.f;
#pragma unroll
            for (int s2 = 0; s2 < 4; ++s2)
#pragma unroll
                for (int q = 0; q < 4; ++q) {
                    const int kk = s2 >> 1, e = 8 * (s2 & 1) + 2 * q;
#if FOLD_M
                    const float p0 = __builtin_amdgcn_exp2f(st[kk][e]), p1 = __builtin_amdgcn_exp2f(st[kk][e + 1]);
#else
                    const float p0 = __builtin_amdgcn_exp2f(st[kk][e] - mrun), p1 = __builtin_amdgcn_exp2f(st[kk][e + 1] - mrun);
#endif
                    ps += p0; ps += p1; pf[s2].u[q] = pack2(p0, p1);
                }
            if (__any(!(ps <= 65536.f) || ps < 7.9e-31f)) {
                float mx = st[0][0];
#pragma unroll
                for (int kk = 0; kk < 2; ++kk)
#pragma unroll
                    for (int e = 0; e < 16; e += 2) mx = fmaxf(fmaxf(mx, st[kk][e]), st[kk][e + 1]);
                mx = fmaxf(mx, __shfl_xor(mx, 32));
                float delta = 0.f;
#if FOLD_M
                if (mx > -1e29f) { const float mn = __uint_as_float(pack2(mrun + mx, 0.f) << 16); delta = mn - mrun; mrun = mn; }
                const float sub = delta;
                { union { bf16x8 v; unsigned u[4]; } qq; qq.u[0] = (lh == 0) ? (pack2(-mrun, 0.f) & 0xffffu) : 0u; qq.u[1] = 0u; qq.u[2] = 0u; qq.u[3] = 0u; qm = qq.v; }
#else
                if (mx > -1e29f) { delta = mx - mrun; mrun = mx; }
                const float sub = mrun;
#endif
                const float alpha = __builtin_amdgcn_exp2f(-delta);
                lrun *= alpha;
#pragma unroll
                for (int d = 0; d < ND; ++d)
#pragma unroll
                    for (int e = 0; e < 16; ++e) ot[d][e] *= alpha;
                ps = 0.f;
#pragma unroll
                for (int s2 = 0; s2 < 4; ++s2)
#pragma unroll
                    for (int q = 0; q < 4; ++q) {
                        const int kk = s2 >> 1, e = 8 * (s2 & 1) + 2 * q;
                        const float p0 = __builtin_amdgcn_exp2f(st[kk][e] - sub), p1 = __builtin_amdgcn_exp2f(st[kk][e + 1] - sub);
                        ps += p0; ps += p1; pf[s2].u[q] = pack2(p0, p1);
                    }
            }
            lrun += ps;
#pragma unroll
            for (int s2 = 0; s2 < 4; ++s2)
#pragma unroll
                for (int d = 0; d < ND; ++d) {
                    const bf16x8 vf = *(const bf16x8*)&sv[32 * d + lr][16 * s2 + 8 * lh];
                    ot[d] = MFMA(vf, pf[s2].v, ot[d]);
                }
        }
        __syncthreads();
    }
#undef FC_TILE
#undef FC_PREFETCH
#undef FC_STORE
    const float ltot = lrun + __shfl_xor(lrun, 32);
    const float inv = 1.f / ltot;
#pragma unroll
    for (int d = 0; d < ND; ++d)
#pragma unroll
        for (int e = 0; e < 16; ++e) ot[d][e] *= inv;
}

DI void diff_item(const P& p, int l, int b, int h8, int qb, char* smem) {
    const int tid_ = tid();
    char* ws_ = launder(p.ws);
    const bf16_t* Z = (const bf16_t*)(ws_ + OFF_Z);
    const bf16_t* VT = (const bf16_t*)(ws_ + OFF_VT);
    bf16_t* OD = (bf16_t*)(ws_ + OFF_O) + (size_t)1 * RB * OLD;
    const float* misc = (const float*)(ws_ + OFF_MISC);
    const int t = tid_, w = t >> 6, ln = t & 63, lr = ln & 31, lh = ln >> 5;
    const int qrow0 = 256 * qb;
    const int t1s = (qb < 32) ? 0 : 128, t1n = (qb < 32) ? 132 : 4;
    f32x16 o0[4];
    NoMask nm;
    const int item_ = h8 + 8 * qb;
    float* dsc = (float*)(ws_ + (item_ < 132 ? OFF_H + (size_t)b * RB * HLD * 2 : OFF_O)) + (size_t)(item_ < 132 ? item_ : item_ - 132) * 32768 + t * 4;
    flash_core<128>(Z + (size_t)qrow0 * ZLD + ZC_DQ + h8 * 128 + 64, Z + ZC_DK + h8 * 128 + 64, VT + (size_t)(1024 + h8 * 128) * VLD, t1s, t1n, 0, 0, nm, o0, smem);
#pragma unroll
    for (int d = 0; d < 4; ++d)
#pragma unroll
        for (int q = 0; q < 4; ++q) *(float4*)(dsc + (size_t)(d * 4 + q) * 2048) = make_float4(o0[d][4 * q], o0[d][4 * q + 1], o0[d][4 * q + 2], o0[d][4 * q + 3]);
    flash_core<128>(Z + (size_t)qrow0 * ZLD + ZC_DQ + h8 * 128, Z + ZC_DK + h8 * 128, VT + (size_t)(1024 + h8 * 128) * VLD, t1s, t1n, 0, 0, nm, o0, smem);
    const float lam = misc[l];
    const float lam_init = 0.8f - 0.6f * expf(-0.3f * (float)l);
    float ss = 0.f;
#pragma unroll
    for (int d = 0; d < 4; ++d)
#pragma unroll
        for (int q = 0; q < 4; ++q) {
            const float4 o1 = *(const float4*)(dsc + (size_t)(d * 4 + q) * 2048);
            float v;
            v = o0[d][4 * q] - lam * o1.x; o0[d][4 * q] = v; ss += v * v;
            v = o0[d][4 * q + 1] - lam * o1.y; o0[d][4 * q + 1] = v; ss += v * v;
            v = o0[d][4 * q + 2] - lam * o1.z; o0[d][4 * q + 2] = v; ss += v * v;
            v = o0[d][4 * q + 3] - lam * o1.w; o0[d][4 * q + 3] = v; ss += v * v;
        }
    ss += __shfl_xor(ss, 32);
    const float rinv = rsqrtf(ss * (1.f / 128.f) + 1e-5f) * (1.f - lam_init);
    const int row = qrow0 + 32 * w + lr;
    const float* g = p.subln_g + l * 128;
#pragma unroll
    for (int d = 0; d < 4; ++d)
#pragma unroll
        for (int q = 0; q < 4; ++q) {
            const int dv = 32 * d + 8 * q + 4 * lh;
            const float4 gv = *(const float4*)(g + dv);
            uint2 v; v.x = pack2(o0[d][4 * q] * rinv * gv.x, o0[d][4 * q + 1] * rinv * gv.y); v.y = pack2(o0[d][4 * q + 2] * rinv * gv.z, o0[d][4 * q + 3] * rinv * gv.w);
            *(uint2*)(OD + (size_t)row * OLD + h8 * 128 + dv) = v;
        }
}
DI void na_item(const P& p, int l, int h16, int it, char* smem) {
    const int tid_ = tid();
    char* ws_ = launder(p.ws);
    const bf16_t* Z = (const bf16_t*)(ws_ + OFF_Z);
    const bf16_t* VT = (const bf16_t*)(ws_ + OFF_VT);
    bf16_t* ON = (bf16_t*)(ws_ + OFF_O) + (size_t)2 * RB * OLD;
    const int t = tid_, w = t >> 6, ln = t & 63, lr = ln & 31, lh = ln >> 5;
    const int qrow0 = 256 * it;
    f32x16 o[2];
    const bf16_t* zq = Z + (size_t)qrow0 * ZLD + ZC_NQ + h16 * 64;
    const bf16_t* zk = Z + ZC_NK + h16 * 64;
    const bf16_t* vt = VT + (size_t)(2048 + h16 * 64) * VLD;
    if (it < 32) {
        float* rp = (float*)(smem + 2 * 27648);
        __syncthreads();
        for (int i = t; i < 465; i += 512) rp[i] = p.rpb[((size_t)l * 16 + h16) * 465 + i] * L2E;
        const int r0 = 4 * it, r1 = r0 + 3;
        const int rs0 = min(max(r0 - 4, 0), 120), rs1 = min(max(r1 - 4, 0), 120);
        NaMask mk;
        mk.r = r0 + (w >> 1); mk.rs = min(max(mk.r - 4, 0), 120);
        mk.j = 32 * (w & 1) + lr; mk.cs = min(max(mk.j - 8, 0), 48); mk.rpb = rp;
        flash_core<64>(zq, zk, vt, rs0, rs1 + 8 - rs0, 128, 4, mk, o, smem);
    } else {
        NoMask nm;
        flash_core<64>(zq, zk, vt, 128, 4, 0, 0, nm, o, smem);
    }
    const int row = qrow0 + 32 * w + lr;
#pragma unroll
    for (int d = 0; d < 2; ++d)
#pragma unroll
        for (int q = 0; q < 4; ++q) {
            const int dv = 32 * d + 8 * q + 4 * lh;
            uint2 v; v.x = pack2(o[d][4 * q], o[d][4 * q + 1]); v.y = pack2(o[d][4 * q + 2], o[d][4 * q + 3]);
            *(uint2*)(ON + (size_t)row * OLD + h16 * 64 + dv) = v;
        }
}

DI int tb_rowbase(int TB) { return TB == 0 ? SEQ : 256 * (TB - 1); }
DI void r1_tile(const P& p, int idx, char* smem) {
    char* ws_ = launder(p.ws);
    const int n = idx & 31, dir = (idx >> 5) & 1, h4 = idx >> 6;
    const int TB = (dir == 0) ? n : (n == 0 ? 0 : 33 - n);
    const int rb = tb_rowbase(TB);
    const bf16_t* A = (const bf16_t*)(ws_ + OFF_VT) + (size_t)(h4 * 256) * VLD + rb;
    const bf16_t* B = (const bf16_t*)(ws_ + OFF_KT) + (size_t)(dir * 1024 + h4 * 256) * VLD + rb;
    bf16_t* C = (bf16_t*)(ws_ + OFF_ST) + ((size_t)(h4 * 2 + dir) * 32 + n) * 65536;
    f32x16 acc[4][2]; zero4(acc);
    gemm_kloop<true>(A, VLD, B, VLD, 256, acc, smem);
    store_swap_bf16(acc, C, 256, 0, 0);
}
DI void r3a_tile(const P& p, int l, int h4, int TB, char* smem) {
    const int tid_ = tid();
    char* ws_ = launder(p.ws);
    const int rb = tb_rowbase(TB);
    const bf16_t* Z = (const bf16_t*)(ws_ + OFF_Z);
    const float* misc = (const float*)(ws_ + OFF_MISC);
    bf16_t* C = (bf16_t*)(ws_ + OFF_ATT) + (size_t)(h4 * 33 + TB) * 65536;
    f32x16 acc[4][2]; zero4(acc);
    gemm_kloop<true>(Z + (size_t)rb * ZLD + ZC_RQ + h4 * 256, ZLD, Z + (size_t)rb * ZLD + ZC_RK + h4 * 256, ZLD, 256, acc, smem);
    const float lgf = misc[8 + l * 8 + h4], lgb = misc[8 + l * 8 + 4 + h4];
    const int t = tid_, w = t >> 6, ln = t & 63, lr = ln & 31, lh = ln >> 5, wm = w >> 2, wn = w & 3;
#pragma unroll
    for (int i = 0; i < 4; ++i)
#pragma unroll
        for (int j = 0; j < 2; ++j) {
            const int qi = 128 * wm + 32 * i + lr;
#pragma unroll
            for (int e = 0; e < 16; ++e) {
                const int kj = 64 * wn + 32 * j + (e & 3) + 8 * (e >> 2) + 4 * lh;
                const int dd = qi - kj;
                const float wf = (dd >= 0) ? __builtin_amdgcn_exp2f(lgf * (float)dd) : 0.f;
                const float wb = (dd <= 0) ? __builtin_amdgcn_exp2f(lgb * (float)(-dd)) : 0.f;
                acc[i][j][e] *= (wf + wb);
            }
        }
    store_swap_bf16(acc, C, 256, 0, 0);
}
DI void r3b_tile(const P& p, int l, int h4, int TB, int mh, char* smem) {
    const int tid_ = tid();
    char* ws_ = launder(p.ws);
    const int rb = tb_rowbase(TB);
    const bf16_t* Z = (const bf16_t*)(ws_ + OFF_Z);
    const bf16_t* VT = (const bf16_t*)(ws_ + OFF_VT);
    const bf16_t* ST = (const bf16_t*)(ws_ + OFF_ST);
    const bf16_t* ATT = (const bf16_t*)(ws_ + OFF_ATT) + (size_t)(h4 * 33 + TB) * 65536 + (size_t)(128 * mh) * 256;
    bf16_t* OR = (bf16_t*)(ws_ + OFF_O);
    const float* misc = (const float*)(ws_ + OFF_MISC);
    const int t = tid_, w = t >> 6, ln = t & 63, lr = ln & 31, lh = ln >> 5, wm = w >> 2, wn = w & 3;
    f32x16 acc[2][2];
    zero4(acc);
    if (TB >= 1) {
        const int nf = TB, nb = 33 - TB;
        const bf16_t* Aq = Z + (size_t)(rb + 128 * mh) * ZLD + ZC_RQ + h4 * 256;
        const float lgf = misc[8 + l * 8 + h4], lgb = misc[8 + l * 8 + 4 + h4];
        gemm_kloop<true, 2>(Aq, ZLD, ST + ((size_t)(h4 * 2 + 1) * 32 + (nb - 1)) * 65536, 256, 256, acc, smem);
#pragma unroll
        for (int i = 0; i < 2; ++i) {
            const int qi = 128 * mh + 64 * wm + 32 * i + lr;
            const float ratio = exp2f(lgb * (float)(256 - qi) - lgf * (float)(qi + 1));
#pragma unroll
            for (int j = 0; j < 2; ++j)
#pragma unroll
                for (int e = 0; e < 16; ++e) acc[i][j][e] *= ratio;
        }
        gemm_kloop<true, 2>(Aq, ZLD, ST + ((size_t)(h4 * 2 + 0) * 32 + (nf - 1)) * 65536, 256, 256, acc, smem);
#pragma unroll
        for (int i = 0; i < 2; ++i) {
            const int qi = 128 * mh + 64 * wm + 32 * i + lr;
            const float sf = exp2f(lgf * (float)(qi + 1));
#pragma unroll
            for (int j = 0; j < 2; ++j)
#pragma unroll
                for (int e = 0; e < 16; ++e) acc[i][j][e] *= sf;
        }
    }
    gemm_kloop<true, 2>(ATT, 256, VT + (size_t)(h4 * 256) * VLD + rb, VLD, 256, acc, smem);
    {
        float2* red = (float2*)smem;
        float s1[2], s2[2];
#pragma unroll
        for (int i = 0; i < 2; ++i) {
            float a = 0.f, q = 0.f;
#pragma unroll
            for (int j = 0; j < 2; ++j)
#pragma unroll
                for (int e = 0; e < 16; ++e) { const float x = acc[i][j][e]; a += x; q += x * x; }
            a += __shfl_xor(a, 32); q += __shfl_xor(q, 32);
            if (lh == 0) red[(64 * wm + 32 * i + lr) * 4 + wn] = make_float2(a, q);
        }
        __syncthreads();
#pragma unroll
        for (int i = 0; i < 2; ++i) {
            const int row = 64 * wm + 32 * i + lr;
            const float2 r0 = red[row * 4 + 0], r1 = red[row * 4 + 1], r2 = red[row * 4 + 2], r3 = red[row * 4 + 3];
            const float mean = (r0.x + r1.x + r2.x + r3.x) * (1.f / 256.f);
            const float var = (r0.y + r1.y + r2.y + r3.y) * (1.f / 256.f) - mean * mean;
            s1[i] = mean; s2[i] = rsqrtf(fmaxf(var, 0.f) + 1e-6f);
        }
#pragma unroll
        for (int i = 0; i < 2; ++i)
#pragma unroll
            for (int j = 0; j < 2; ++j) {
                const int row = rb + 128 * mh + 64 * wm + 32 * i + lr, nb = 64 * wn + 32 * j + 4 * lh;
                const bf16_t* gp = Z + (size_t)row * ZLD + ZC_RG + h4 * 256 + nb;
                bf16_t* op = OR + (size_t)row * OLD + h4 * 256 + nb;
#pragma unroll
                for (int q = 0; q < 4; ++q) {
                    const u32x2 gv = *(const u32x2*)(gp + 8 * q);
                    const float g0 = __uint_as_float(gv.x << 16), g1 = __uint_as_float(gv.x & 0xffff0000u), g2 = __uint_as_float(gv.y << 16), g3 = __uint_as_float(gv.y & 0xffff0000u);
                    const float v0 = (acc[i][j][4 * q] - s1[i]) * s2[i] * g0 * sigmoidf_(g0);
                    const float v1 = (acc[i][j][4 * q + 1] - s1[i]) * s2[i] * g1 * sigmoidf_(g1);
                    const float v2 = (acc[i][j][4 * q + 2] - s1[i]) * s2[i] * g2 * sigmoidf_(g2);
                    const float v3 = (acc[i][j][4 * q + 3] - s1[i]) * s2[i] * g3 * sigmoidf_(g3);
                    u32x2 u; u.x = pack2(v0, v1); u.y = pack2(v2, v3);
                    *(u32x2*)(op + 8 * q) = u;
                }
            }
    }
}
DI void phase_scan(const P& p, int l) {
    const int tid_ = tid();
    char* ws_ = launder(p.ws);
    bf16_t* ST = (bf16_t*)(ws_ + OFF_ST);
    const float* misc = (const float*)(ws_ + OFF_MISC);
    for (int idx = blockIdx.x * 512 + tid_; idx < 8 * 16384; idx += gridDim.x * 512) {
        const int seq = idx >> 14, e4 = idx & 16383, h4 = seq >> 1, dir = seq & 1;
        const float cdec = exp2f(misc[8 + l * 8 + dir * 4 + h4] * 256.f);
        bf16_t* base = ST + (size_t)seq * 32 * 65536 + (size_t)e4 * 4;
        float r0 = 0.f, r1 = 0.f, r2 = 0.f, r3 = 0.f;
#pragma unroll 8
        for (int n = 0; n < 32; ++n) {
            uint2* pp = (uint2*)(base + (size_t)n * 65536);
            const uint2 v = *pp;
            r0 = r0 * cdec + __uint_as_float(v.x << 16); r1 = r1 * cdec + __uint_as_float(v.x & 0xffff0000u);
            r2 = r2 * cdec + __uint_as_float(v.y << 16); r3 = r3 * cdec + __uint_as_float(v.y & 0xffff0000u);
            uint2 o; o.x = pack2(r0, r1); o.y = pack2(r2, r3);
            *pp = o;
        }
    }
}
DI void phase_r4(const P& p, int nrows) {
    const int tid_ = tid();
    char* ws_ = launder(p.ws);
    bf16_t* OR = (bf16_t*)(ws_ + OFF_O);
    const bf16_t* Z = (const bf16_t*)(ws_ + OFF_Z);
    const int lane = tid_ & 63, wv = tid_ >> 6;
    for (int idx = blockIdx.x * 8 + wv; idx < nrows * 4; idx += gridDim.x * 8) {
        const int row = idx >> 2, h4 = idx & 3;
        bf16_t* op = OR + (size_t)row * OLD + h4 * 256 + 4 * lane;
        const uint2 ov = *(const uint2*)op;
        const uint2 gv = *(const uint2*)(Z + (size_t)row * ZLD + ZC_RG + h4 * 256 + 4 * lane);
        float v[4] = {__uint_as_float(ov.x << 16), __uint_as_float(ov.x & 0xffff0000u), __uint_as_float(ov.y << 16), __uint_as_float(ov.y & 0xffff0000u)};
        const float g[4] = {__uint_as_float(gv.x << 16), __uint_as_float(gv.x & 0xffff0000u), __uint_as_float(gv.y << 16), __uint_as_float(gv.y & 0xffff0000u)};
        const float mean = wave_sum(v[0] + v[1] + v[2] + v[3]) * (1.f / 256.f);
        float q = 0.f;
#pragma unroll
        for (int i = 0; i < 4; ++i) { const float d = v[i] - mean; q += d * d; }
        const float rstd = rsqrtf(wave_sum(q) * (1.f / 256.f) + 1e-6f);
#pragma unroll
        for (int i = 0; i < 4; ++i) v[i] = (v[i] - mean) * rstd * g[i] * sigmoidf_(g[i]);
        uint2 o; o.x = pack2(v[0], v[1]); o.y = pack2(v[2], v[3]);
        *(uint2*)op = o;
    }
}

DI void phase_s2(const P& p, int l, int b, char* smem) {
    const int nqb = (l == 0) ? 33 : 32, nTB = (l == 0) ? 33 : 32, tb0 = (l == 0) ? 0 : 1;
    const int nDiff = 8 * nqb, nNA = 16 * nqb, nR1 = 256, nR3a = 4 * nTB;
    for (int i = blockIdx.x; i < nDiff; i += gridDim.x) diff_item(p, l, b, i & 7, i >> 3, smem);
    unsigned* ctr = (unsigned*)(p.ws + OFF_BAR) + 32 + l * 4 + b;
    volatile LAS unsigned* slot = (volatile LAS unsigned*)(smem + 147440);
    const int nq = nR3a + nR1 + nNA;
    for (;;) {
        __syncthreads();
        if (threadIdx.x == 0) *slot = xb_add(ctr, 1u);
        __syncthreads();
        int i = (int)*slot;
        if (i >= nq) break;
        if (i < nR3a) { r3a_tile(p, l, i & 3, tb0 + (i >> 2), smem); continue; }
        i -= nR3a;
        if (i < nR1) { r1_tile(p, i, smem); continue; }
        i -= nR1;
        na_item(p, l, i & 15, i >> 4, smem);
    }
}
DI void phase_r3b(const P& p, int l, char* smem) {
    const int nTB = (l == 0) ? 33 : 32, tb0 = (l == 0) ? 0 : 1;
    for (int i = blockIdx.x; i < 8 * nTB; i += gridDim.x) {
        const int mh = i & 1, h4 = (i >> 1) & 3, TB = tb0 + (i >> 3);
        r3b_tile(p, l, h4, TB, mh, smem);
    }
}

template <int MI>
DI void merge_tile(const P& p, size_t ooff, size_t obr, size_t goff, int gld, size_t moff, int m0, int n0, char* smem) {
    const int tid_ = tid();
    char* ws_ = launder(p.ws);
    const bf16_t* O = (const bf16_t*)(ws_ + ooff);
    const bf16_t* WP = (const bf16_t*)(ws_ + OFF_WP);
    const bf16_t* G = (const bf16_t*)(ws_ + goff);
    bf16_t* Mb = (bf16_t*)(ws_ + moff);
    const int t = tid_, w = t >> 6, ln = t & 63, lr = ln & 31, lh = ln >> 5, wm = w >> 2, wn = w & 3;
    f32x16 tot[MI][2];
    zero4(tot);
    for (int br = 0; br < 3; ++br) {
        f32x16 acc[MI][2];
        zero4(acc);
        gemm_kloop<true, MI>(O + (size_t)br * obr + (size_t)m0 * OLD, OLD, WP + (size_t)br * 1024 * WK + (size_t)n0 * WK, WK, D, acc, smem);
#pragma unroll
        for (int i = 0; i < MI; ++i)
#pragma unroll
            for (int j = 0; j < 2; ++j) {
                const int m = m0 + 32 * MI * wm + 32 * i + lr, nb = n0 + 64 * wn + 32 * j + 4 * lh;
                const bf16_t* gp = G + (size_t)m * gld + br * 1024 + nb;
#pragma unroll
                for (int q = 0; q < 4; ++q) {
                    const u32x2 gv = *(const u32x2*)(gp + 8 * q);
                    tot[i][j][4 * q] += __uint_as_float(gv.x << 16) * acc[i][j][4 * q];
                    tot[i][j][4 * q + 1] += __uint_as_float(gv.x & 0xffff0000u) * acc[i][j][4 * q + 1];
                    tot[i][j][4 * q + 2] += __uint_as_float(gv.y << 16) * acc[i][j][4 * q + 2];
                    tot[i][j][4 * q + 3] += __uint_as_float(gv.y & 0xffff0000u) * acc[i][j][4 * q + 3];
                }
            }
    }
    store_swap_bf16(tot, Mb, HLD, m0, n0);
}
DI void phase_merge(const P& p, int l, int b, char* smem) {
    const int nitems = 256 + (l == 0 ? 16 : 0);
    for (int idx = blockIdx.x; idx < nitems; idx += gridDim.x) {
        if (idx < 256) merge_tile<2>(p, OFF_O, (size_t)RB * OLD, OFF_Z + (size_t)ZC_GA * 2, ZLD, OFF_H + (size_t)b * RB * HLD * 2, (idx >> 2) * 128, (idx & 3) * 256, smem);
        else {
            char* ws_ = launder(p.ws);
            const int j = idx - 256, t = tid();
            for (int c = t; c < 16 * 768; c += 512) {
                const int rr = 16 * j + c / 768, k = c % 768;
                if (k < 384) {
                    const int br = k >> 7, cc = (k & 127) * 8;
                    *(u32x4*)((bf16_t*)(ws_ + OFF_OC) + ((size_t)br * 1024 + b * 256 + rr) * OLD + cc) = *(const u32x4*)((const bf16_t*)(ws_ + OFF_O) + ((size_t)br * RB + SEQ + rr) * OLD + cc);
                } else {
                    const int cc = (k - 384) * 8;
                    *(u32x4*)((bf16_t*)(ws_ + OFF_GC) + (size_t)(b * 256 + rr) * 3072 + cc) = *(const u32x4*)((const bf16_t*)(ws_ + OFF_Z) + (size_t)(SEQ + rr) * ZLD + ZC_GA + cc);
                }
            }
        }
    }
}
template <int MI>
DI void wo_tile(const P& p, size_t moff, int m0, int n0, char* smem) {
    char* ws_ = launder(p.ws);
    const bf16_t* Mb = (const bf16_t*)(ws_ + moff);
    const bf16_t* W = (const bf16_t*)(ws_ + OFF_WO);
    float* Y = (float*)(ws_ + OFF_ST);
    f32x16 acc[MI][2]; zero4(acc);
    gemm_kloop<true, MI>(Mb + (size_t)m0 * HLD, HLD, W + (size_t)n0 * WK, WK, D, acc, smem);
    store_swap_f32(acc, Y, D, m0, n0);
}
DI void phase_wo(const P& p, int b, char* smem) {
    for (int idx = blockIdx.x; idx < 256; idx += gridDim.x) wo_tile<2>(p, OFF_H + (size_t)b * RB * HLD * 2, (idx >> 2) * 128, (idx & 3) * 256, smem);
}
template <int MI>
DI void ff1_tile(const P& p, size_t hoff, int m0, int n0, char* smem) {
    char* ws_ = launder(p.ws);
    const bf16_t* Hb = (const bf16_t*)(ws_ + hoff);
    const bf16_t* W = (const bf16_t*)(ws_ + OFF_WF1);
    bf16_t* U = (bf16_t*)(ws_ + OFF_Z);
    f32x16 acc[MI][2]; zero4(acc);
    gemm_kloop<true, MI>(Hb + (size_t)m0 * HLD, HLD, W + (size_t)n0 * WK, WK, D, acc, smem);
#pragma unroll
    for (int i = 0; i < MI; ++i)
#pragma unroll
        for (int j = 0; j < 2; ++j)
#pragma unroll
            for (int e = 0; e < 16; ++e) { const float v = fmaxf(acc[i][j][e], 0.f); acc[i][j][e] = v * v; }
    store_swap_bf16(acc, U, ULD, m0, n0);
}
DI void phase_ff1(const P& p, int b, char* smem) {
    for (int idx = blockIdx.x; idx < 512; idx += gridDim.x) ff1_tile<4>(p, OFF_H + (size_t)b * RB * HLD * 2, (idx >> 4) * 256, (idx & 15) * 256, smem);
}
template <int MI>
DI void ff2_tile(const P& p, int m0, int n0, char* smem) {
    char* ws_ = launder(p.ws);
    const bf16_t* U = (const bf16_t*)(ws_ + OFF_Z);
    const bf16_t* W = (const bf16_t*)(ws_ + OFF_WF2);
    float* Y2 = (float*)(ws_ + OFF_ST);
    f32x16 acc[MI][2]; zero4(acc);
    gemm_kloop<true, MI>(U + (size_t)m0 * ULD, ULD, W + (size_t)n0 * WK2, WK2, DFF, acc, smem);
    store_swap_f32(acc, Y2, D, m0, n0);
}
DI void phase_ff2(const P& p, char* smem) {
    for (int idx = blockIdx.x; idx < 256; idx += gridDim.x) ff2_tile<2>(p, (idx >> 2) * 128, (idx & 3) * 256, smem);
}

#ifndef PHASE_MASK
#define PHASE_MASK 0xffffffffu
#endif
#define PH(n, call) do { if ((PHASE_MASK >> (n)) & 1u) { call; } } while (0)
__global__ void __launch_bounds__(512, 2) fwd_megakernel(P p) {
    __shared__ __attribute__((aligned(16))) char smem[147456];
    __shared__ uint4 xb_words;
    cg::grid_group grid = cg::this_grid();
    if (threadIdx.x == 0) xb_words = make_uint4(0u, 0u, 0u, 0u);
    __syncthreads();
    XcdBarrier bar = xcd_barrier_post((unsigned*)(p.ws + OFF_BAR), (volatile LAS unsigned*)&xb_words);

    PH(0, phase_convert(p, 0, smem));
    PH(1, phase_tables(p));
    PH(1, phase_misc(p));
    PH(2, phase_mod(p, smem));
    if (p.out == nullptr) grid.sync();
    xcd_barrier(bar);
    PH(3, phase_lnmod0(p));
    xcd_barrier(bar);
#pragma unroll 1
    for (int l = 0; l < 2; ++l) {
        if (l == 1) { PH(0, phase_convert(p, 1, smem)); xcd_barrier(bar); }
#pragma unroll 1
        for (int b = 0; b <= NBATCH; ++b) {
            if (b > 0) PH(14, phase_ln2(p, l, b - 1, SEQ, 0));
            if (b < NBATCH) PH(4, phase_inproj(p, l, b, smem));
            xcd_barrier(bar);
            if (b == NBATCH) break;
            PH(5, phase_s2(p, l, b, smem));          xcd_barrier(bar);
            PH(6, phase_scan(p, l));              xcd_barrier(bar);
            PH(7, phase_r3b(p, l, smem));         xcd_barrier(bar);
            PH(9, phase_merge(p, l, b, smem));    xcd_barrier(bar);
            PH(10, phase_wo(p, b, smem));         xcd_barrier(bar);
            PH(11, phase_ln1(p, l, b, SEQ, 0));   xcd_barrier(bar);
            PH(12, phase_ff1(p, b, smem));        xcd_barrier(bar);
            PH(13, phase_ff2(p, smem));           xcd_barrier(bar);
        }
        if (l == 0) {
            constexpr size_t MC = OFF_KT, HC = OFF_KT + (4u << 20);
            for (int idx = blockIdx.x; idx < 64; idx += gridDim.x)
                merge_tile<1>(p, OFF_OC, (size_t)1024 * OLD, OFF_GC, 3072, MC, (idx >> 2) * 64, (idx & 3) * 256, smem);
            xcd_barrier(bar);
            for (int idx = blockIdx.x; idx < 64; idx += gridDim.x) wo_tile<1>(p, MC, (idx >> 2) * 64, (idx & 3) * 256, smem);
            xcd_barrier(bar);
            phase_ln1(p, 0, 0, 1024, 1);
            xcd_barrier(bar);
            for (int idx = blockIdx.x; idx < 256; idx += gridDim.x) ff1_tile<1>(p, HC, (idx >> 4) * 64, (idx & 15) * 256, smem);
            xcd_barrier(bar);
            for (int idx = blockIdx.x; idx < 64; idx += gridDim.x) ff2_tile<1>(p, (idx >> 2) * 64, (idx & 3) * 256, smem);
            xcd_barrier(bar);
            phase_ln2(p, 0, 0, 1024, 1);
            xcd_barrier(bar);
        }
    }
}

extern "C" void kernel_launch(void* const* d_in, const int* in_sizes, int n_in, void* d_out, int out_size, void* d_ws, size_t ws_size, hipStream_t stream) {
    static int grid_blocks = 0;
    if (!grid_blocks) {
        int dev = 0, cus = 0, per_cu = 0;
        hipGetDevice(&dev);
        hipDeviceGetAttribute(&cus, hipDeviceAttributeMultiprocessorCount, dev);
        hipOccupancyMaxActiveBlocksPerMultiprocessor(&per_cu, fwd_megakernel, 512, 0);
        if (per_cu > 1) per_cu = 1;
        if (per_cu < 1) per_cu = 1;
        grid_blocks = cus * per_cu;
    }
    if (ws_size < WS_NEED) { fprintf(stderr, "workspace too small: %zu < %zu\n", ws_size, (size_t)WS_NEED); return; }
    P p{};
    const float** pp = (const float**)&p;
    for (int i = 0; i < 25; ++i) pp[i] = (const float*)d_in[i];
    p.out = (float*)d_out;
    p.ws = (char*)d_ws;
    hipMemsetAsync((char*)d_ws + OFF_BAR, 0, 16384, stream);
    void* args[] = {&p};
    hipError_t e = hipLaunchCooperativeKernel((void*)fwd_megakernel, dim3(grid_blocks), dim3(512), args, 0, stream);
    if (e != hipSuccess) fprintf(stderr, "cooperative launch failed: %s (grid %d)\n", hipGetErrorString(e), grid_blocks);
}
```

```cpp
#include <hip/hip_runtime.h>
#include <hip/hip_cooperative_groups.h>
#include <cstdio>
#include <cstdint>
namespace cg = cooperative_groups;
#ifndef PIPE4
#define PIPE4 0
#endif
#ifndef FOLD_M
#define FOLD_M 1
#endif
#ifndef S2MASK
#define S2MASK 15
#endif

typedef unsigned short bf16_t;
typedef short bf16x8 __attribute__((ext_vector_type(8)));
typedef float f32x16 __attribute__((ext_vector_type(16)));
typedef unsigned u32x4 __attribute__((ext_vector_type(4)));
typedef unsigned u32x2 __attribute__((ext_vector_type(2)));
#define DI __device__ __forceinline__
#define MFMA(a, b, c) __builtin_amdgcn_mfma_f32_32x32x16_bf16((a), (b), (c), 0, 0, 0)
#define LAS __attribute__((address_space(3)))

constexpr int D = 1024, SEQ = 8192, CTXL = 256, NBATCH = 4, RB = 8448  ;
constexpr int ZLD = 10304, VLD = 8448, INW = 13312, DFF = 4096;
constexpr int HLD = 1088, OLD = 1088, WK = 1088, WK2 = 4160, ULD = 4160;
constexpr int ZC_RQ = 0, ZC_RK = 1024, ZC_RG = 2048, ZC_DQ = 3072, ZC_DK = 4096, ZC_NQ = 5120, ZC_NK = 6144, ZC_GA = 7168;
constexpr float L2E = 1.4426950408889634f;

constexpr size_t OFF_BAR = 0;
constexpr size_t OFF_WIN = 16384;
constexpr size_t OFF_WP  = OFF_WIN + 13312ull * WK * 2;
constexpr size_t OFF_WO  = OFF_WP + 3ull * 1024 * WK * 2;
constexpr size_t OFF_WF1 = OFF_WO + 1024ull * WK * 2;
constexpr size_t OFF_WF2 = OFF_WF1 + 4096ull * WK * 2;
constexpr size_t OFF_TAB = OFF_WF2 + 1024ull * WK2 * 2;
constexpr size_t OFF_MOD = OFF_TAB + 160ull * 8192 * 8;
constexpr size_t OFF_MISC = OFF_MOD + 2ull * 5 * 6144 * 4;
constexpr size_t OFF_XC = OFF_MISC + 4096;
constexpr size_t OFF_H = OFF_XC + 1024ull * 1024 * 4;
constexpr size_t OFF_Z = OFF_H + 33792ull * HLD * 2;
constexpr size_t OFF_VT = OFF_Z + 8448ull * ZLD * 2;
constexpr size_t OFF_KT = OFF_VT + 3072ull * 8448 * 2;
constexpr size_t OFF_O = OFF_KT + 2048ull * 8448 * 2;
constexpr size_t OFF_ST = OFF_O + 3ull * 8448 * OLD * 2;
constexpr size_t OFF_ATT = OFF_ST + 256ull * 65536 * 2;
constexpr size_t OFF_OC = OFF_ATT + 132ull * 65536 * 2;
constexpr size_t OFF_GC = OFF_OC + 3ull * 1024 * OLD * 2;
constexpr size_t WS_NEED = OFF_GC + 1024ull * 3072 * 2;
static_assert(132ull * 131072 <= 8448ull * HLD * 2 && 132ull * 131072 <= 8448ull * OLD * 2, "diff scratch overlay");
static_assert(8448ull * ULD * 2 <= 8448ull * ZLD * 2, "U overlay");

struct P {
    const float *x, *c, *ctx, *c_ctx, *w_mod, *b_mod, *w_in, *dec_f, *dec_b, *lq1, *lk1, *lq2, *lk2, *subln_g, *rpb,
        *w_pa, *w_pb, *w_pc, *w_o, *ln1_g, *ln1_b, *w_ff1, *w_ff2, *ln2_g, *ln2_b;
    float* out;
    char* ws;
};

DI int tid() { int t = threadIdx.x; asm volatile("" : "+v"(t)); return t; }
DI char* launder(char* q) { size_t off = 0; asm volatile("" : "+s"(off)); return q + off; }
typedef float f32x2_ __attribute__((ext_vector_type(2)));
typedef __bf16 bf16x2_ __attribute__((ext_vector_type(2)));
DI unsigned pack2(float lo, float hi) { f32x2_ v = {lo, hi}; bf16x2_ b = __builtin_convertvector(v, bf16x2_); return __builtin_bit_cast(unsigned, b); }
DI unsigned short f2bf(float x) { return (unsigned short)(pack2(x, 0.f) & 0xffffu); }
DI float wave_sum(float v) { for (int o = 32; o > 0; o >>= 1) v += __shfl_xor(v, o); return v; }
DI float sigmoidf_(float x) { return 1.f / (1.f + __expf(-x)); }
template <int MI>
DI void zero4(f32x16 (&a)[MI][2]) {
#pragma unroll
    for (int i = 0; i < MI; ++i)
#pragma unroll
        for (int j = 0; j < 2; ++j)
#pragma unroll
            for (int e = 0; e < 16; ++e) a[i][j][e] = 0.f;
}

#define XB_TMO      128
#define XB_XCNT(j)  (256  + 64 * (j))
#define XB_XSUB(j)  (1280 + 64 * (j))
#define XB_XGEN(j)  (2304 + 64 * (j))
#define XB_TOP      3328
#define XB_TOPGEN   3392
#define XCD_BAR_WORDS 3456
#define XB_SPIN_CAP (1u << 23)
DI unsigned xb_ld(unsigned* p) { return __hip_atomic_load(p, __ATOMIC_RELAXED, __HIP_MEMORY_SCOPE_AGENT); }
DI unsigned xb_add(unsigned* p, unsigned v) { return __hip_atomic_fetch_add(p, v, __ATOMIC_RELAXED, __HIP_MEMORY_SCOPE_AGENT); }
DI unsigned xb_xcc_id() { return (unsigned)__builtin_amdgcn_s_getreg((3 << 11) | 20) & 0xFu; }
#define XB_SPIN(cond, bar) do { unsigned _sp = 0; while (cond) { __builtin_amdgcn_s_sleep(1); \
    if ((++_sp & 255u) == 0u) { if (xb_ld(&(bar)[XB_TMO])) break; if (_sp > XB_SPIN_CAP) { atomicAdd(&(bar)[XB_TMO], 1u); break; } } } } while (0)
struct XcdBarrier { unsigned* bar; unsigned x; volatile LAS unsigned* st; };
DI XcdBarrier xcd_barrier_post(unsigned* bar, volatile LAS unsigned* st) {
    XcdBarrier b; b.bar = bar; b.x = xb_xcc_id(); b.st = st;
    if (threadIdx.x == 0) (void)xb_add(&bar[XB_XCNT(b.x)], 1u);
    return b;
}
DI void xcd_barrier_complete(unsigned* bar, unsigned x, unsigned& nloc, unsigned& nx) {
    const unsigned G = gridDim.x * gridDim.y * gridDim.z;
    unsigned sum, cnt, mine, sp = 0u;
    for (;;) {
        sum = 0u; cnt = 0u; mine = 0u;
#pragma unroll
        for (unsigned j = 0; j < 16; ++j) { const unsigned c = xb_ld(&bar[XB_XCNT(j)]); sum += c; cnt += (c > 0u) ? 1u : 0u; mine = (j == x) ? c : mine; }
        if (sum == G) break;
        __builtin_amdgcn_s_sleep(1);
        if ((++sp & 255u) == 0u) { if (xb_ld(&bar[XB_TMO])) break; if (sp > XB_SPIN_CAP) { atomicAdd(&bar[XB_TMO], 1u); break; } }
    }
    nloc = mine > 0u ? mine : 1u; nx = cnt > 0u ? cnt : 1u;
}
DI void xcd_barrier(const XcdBarrier& b) {
    asm volatile("s_waitcnt vmcnt(0)" ::: "memory");
    __syncthreads();
    if (threadIdx.x == 0) {
        unsigned* bar = (unsigned*)launder((char*)b.bar);
        __builtin_amdgcn_s_waitcnt(0);
        unsigned nloc = b.st[0], nx = b.st[1];
        if (nloc == 0u) { xcd_barrier_complete(bar, b.x, nloc, nx); b.st[0] = nloc; b.st[1] = nx; }
        const unsigned old = xb_add(&bar[XB_XSUB(b.x)], 1u);
        const unsigned gen = old / nloc;
        if (old + 1u == (gen + 1u) * nloc) {
            __builtin_amdgcn_fence(__ATOMIC_RELEASE, "agent");
            asm volatile("s_waitcnt vmcnt(0)" ::: "memory");
            const unsigned og = xb_add(&bar[XB_TOP], 1u);
            const unsigned tg = og / nx;
            if (og + 1u == (tg + 1u) * nx) xb_add(&bar[XB_TOPGEN], 1u);
            else XB_SPIN(xb_ld(&bar[XB_TOPGEN]) == tg, bar);
            __builtin_amdgcn_fence(__ATOMIC_ACQUIRE, "agent");
            xb_add(&bar[XB_XGEN(b.x)], 1u);
            asm volatile("s_waitcnt vmcnt(0)" ::: "memory");
        } else {
            XB_SPIN(xb_ld(&bar[XB_XGEN(b.x)]) == gen, bar);
            __builtin_amdgcn_fence(__ATOMIC_ACQUIRE, "agent");
            asm volatile("s_waitcnt vmcnt(0)" ::: "memory");
        }
    }
    __syncthreads();
}

template <bool SWAP, int MI = 4>
DI void gemm_kloop(const bf16_t* __restrict__ A, int lda, const bf16_t* __restrict__ B, int ldb, int K, f32x16 (&acc)[MI][2], char* smem) {
    const int tid_ = tid();
    const int t = tid_, r = t >> 3, c = (t & 7) * 8;
    const int w = t >> 6, l = t & 63, lr = l & 31, lh = l >> 5, wm = w >> 2, wn = w & 3;
    const bf16_t* pa = A + (size_t)r * lda + c;
    const bf16_t* pb = B + (size_t)r * ldb + c;
    u32x4 ra[MI], rb[4];
    const int nk = K >> 6;
    __syncthreads();
    {
        bf16_t(*sa_)[72] = (bf16_t(*)[72])smem; bf16_t(*sb_)[72] = (bf16_t(*)[72])(smem + 36864);
#pragma unroll
        for (int i = 0; i < MI; ++i) ra[i] = *(const u32x4*)(pa + (size_t)(64 * i) * lda);
#pragma unroll
        for (int i = 0; i < 4; ++i) rb[i] = *(const u32x4*)(pb + (size_t)(64 * i) * ldb);
#pragma unroll
        for (int i = 0; i < MI; ++i) *(u32x4*)&sa_[r + 64 * i][c] = ra[i];
#pragma unroll
        for (int i = 0; i < 4; ++i) *(u32x4*)&sb_[r + 64 * i][c] = rb[i];
        if (nk > 1) {
#pragma unroll
            for (int i = 0; i < MI; ++i) ra[i] = *(const u32x4*)(pa + (size_t)(64 * i) * lda + 64);
#pragma unroll
            for (int i = 0; i < 4; ++i) rb[i] = *(const u32x4*)(pb + (size_t)(64 * i) * ldb + 64);
        }
    }
    __syncthreads();
    for (int kt = 0; kt < nk; ++kt) {
        const bf16_t(*sa)[72] = (const bf16_t(*)[72])(smem + (kt & 1) * 73728);
        const bf16_t(*sb)[72] = (const bf16_t(*)[72])(smem + (kt & 1) * 73728 + 36864);
        bf16_t(*sa_)[72] = (bf16_t(*)[72])(smem + ((kt + 1) & 1) * 73728);
        bf16_t(*sb_)[72] = (bf16_t(*)[72])(smem + ((kt + 1) & 1) * 73728 + 36864);
        const bool st = kt + 1 < nk, ld = kt + 2 < nk;
        const int k2 = (kt + 2) * 64;
        constexpr int NF = (MI <= 2 || PIPE4) ? 2 : 1;
        bf16x8 fa[NF][MI], fb[NF][2];
        if (NF == 2) {
#pragma unroll
            for (int i = 0; i < MI; ++i) fa[0][i] = *(const bf16x8*)&sa[32 * MI * wm + 32 * i + lr][8 * lh];
#pragma unroll
            for (int j = 0; j < 2; ++j) fb[0][j] = *(const bf16x8*)&sb[64 * wn + 32 * j + lr][8 * lh];
        }
#pragma unroll
        for (int s = 0; s < 4; ++s) {
            const int cur = (NF == 2) ? (s & 1) : 0, nxt = (NF == 2) ? ((s + 1) & 1) : 0, sr = (NF == 2) ? s + 1 : s;
            if (NF == 1 || s < 3) {
#pragma unroll
                for (int i = 0; i < MI; ++i) fa[nxt][i] = *(const bf16x8*)&sa[32 * MI * wm + 32 * i + lr][16 * sr + 8 * lh];
#pragma unroll
                for (int j = 0; j < 2; ++j) fb[nxt][j] = *(const bf16x8*)&sb[64 * wn + 32 * j + lr][16 * sr + 8 * lh];
            }
#pragma unroll
            for (int i = 0; i < MI; ++i)
#pragma unroll
                for (int j = 0; j < 2; ++j) acc[i][j] = SWAP ? MFMA(fb[cur][j], fa[cur][i], acc[i][j]) : MFMA(fa[cur][i], fb[cur][j], acc[i][j]);
            if (s < MI) {
                if (st) *(u32x4*)&sa_[r + 64 * s][c] = ra[s];
                if (ld) ra[s] = *(const u32x4*)(pa + (size_t)(64 * s) * lda + k2);
            }
            if (st) *(u32x4*)&sb_[r + 64 * s][c] = rb[s];
            if (ld) rb[s] = *(const u32x4*)(pb + (size_t)(64 * s) * ldb + k2);
            __builtin_amdgcn_sched_barrier(0);
        }
        __syncthreads();
    }
}

template <int MI>
DI void store_swap_bf16(const f32x16 (&acc)[MI][2], bf16_t* C, int ldc, int m0, int n0) {
    const int tid_ = tid();
    const int t = tid_, w = t >> 6, l = t & 63, lr = l & 31, lh = l >> 5, wm = w >> 2, wn = w & 3;
#pragma unroll
    for (int i = 0; i < MI; ++i)
#pragma unroll
        for (int j = 0; j < 2; ++j) {
            const int m = m0 + 32 * MI * wm + 32 * i + lr, nb = n0 + 64 * wn + 32 * j + 4 * lh;
#pragma unroll
            for (int q = 0; q < 4; ++q) {
                uint2 v; v.x = pack2(acc[i][j][4 * q], acc[i][j][4 * q + 1]); v.y = pack2(acc[i][j][4 * q + 2], acc[i][j][4 * q + 3]);
                *(uint2*)(C + (size_t)m * ldc + nb + 8 * q) = v;
            }
        }
}
template <int MI>
DI void store_swap_f32(const f32x16 (&acc)[MI][2], float* C, int ldc, int m0, int n0) {
    const int tid_ = tid();
    const int t = tid_, w = t >> 6, l = t & 63, lr = l & 31, lh = l >> 5, wm = w >> 2, wn = w & 3;
#pragma unroll
    for (int i = 0; i < MI; ++i)
#pragma unroll
        for (int j = 0; j < 2; ++j) {
            const int m = m0 + 32 * MI * wm + 32 * i + lr, nb = n0 + 64 * wn + 32 * j + 4 * lh;
#pragma unroll
            for (int q = 0; q < 4; ++q) {
                float4 v = make_float4(acc[i][j][4 * q], acc[i][j][4 * q + 1], acc[i][j][4 * q + 2], acc[i][j][4 * q + 3]);
                *(float4*)(C + (size_t)m * ldc + nb + 8 * q) = v;
            }
        }
}

DI int ret_perm(int c) { const int G = c >> 4, w = c & 15; return (w < 8) ? (8 * G + w) : (128 + 8 * G + (w - 8)); }
DI int diff_perm(int c) { const int G = c >> 4, w = c & 15, axis = G >> 1, j = 8 * (G & 1) + (w & 7); return 32 * axis + ((w < 8) ? 0 : 16) + j; }
DI int inproj_src(int n) {
    const int g = n >> 10, c = n & 1023;
    switch (g) {
        case 0: return 0 + (c & ~255) + ret_perm(c & 255);
        case 1: return 1024 + (c & ~255) + ret_perm(c & 255);
        case 2: return 3072 + c;
        case 3: return 4096 + (c & ~63) + diff_perm(c & 63);
        case 4: return 5120 + (c & ~63) + diff_perm(c & 63);
        case 5: return 7168 + c;
        case 6: return 8192 + c;
        case 7: return 10240 + c;
        case 8: return 11264 + c;
        case 9: return 12288 + c;
        case 10: return 2048 + c;
        case 11: return 6144 + c;
        default: return 9216 + c;
    }
}
DI void convert_tile(const float* __restrict__ src, int Nsrc, bf16_t* __restrict__ dst, int dld, int n0, int k0, bool inmap, char* smem) {
    const int tid_ = tid();
    float* tl = (float*)smem;
    const int t = tid_, tx = t & 63, ty = t >> 6;
    const int ncol = inmap ? inproj_src(n0 + tx) : (n0 + tx);
    __syncthreads();
#pragma unroll 4
    for (int i = 0; i < 8; ++i) { const int ky = ty + 8 * i; tl[ky * 65 + tx] = src[(size_t)(k0 + ky) * Nsrc + ncol]; }
    __syncthreads();
#pragma unroll 4
    for (int i = 0; i < 8; ++i) { const int ny = ty + 8 * i; dst[(size_t)(n0 + ny) * dld + k0 + tx] = f2bf(tl[tx * 65 + ny]); }
}
DI void phase_convert(const P& p, int l, char* smem) {
    char* ws_ = launder(p.ws);
    for (int idx = blockIdx.x; idx < 6400; idx += gridDim.x) {
        if (idx < 3328) {
            convert_tile(p.w_in + (size_t)l * 1024 * INW, INW, (bf16_t*)(ws_ + OFF_WIN), WK, (idx >> 4) * 64, (idx & 15) * 64, true, smem);
        } else if (idx < 4352) {
            const int j = idx - 3328, m = j >> 8, tt = j & 255;
            const float* src = (m == 0 ? p.w_pa : m == 1 ? p.w_pb : m == 2 ? p.w_pc : p.w_o) + (size_t)l * 1024 * 1024;
            bf16_t* dst = (bf16_t*)(ws_ + (m < 3 ? OFF_WP + (size_t)m * 1024 * WK * 2 : OFF_WO));
            convert_tile(src, 1024, dst, WK, (tt >> 4) * 64, (tt & 15) * 64, false, smem);
        } else if (idx < 5376) {
            const int j = idx - 4352;
            convert_tile(p.w_ff1 + (size_t)l * 1024 * DFF, DFF, (bf16_t*)(ws_ + OFF_WF1), WK, (j >> 4) * 64, (j & 15) * 64, false, smem);
        } else {
            const int j = idx - 5376;
            convert_tile(p.w_ff2 + (size_t)l * DFF * 1024, 1024, (bf16_t*)(ws_ + OFF_WF2), WK2, (j >> 6) * 64, (j & 63) * 64, false, smem);
        }
    }
}

DI void sincos_tab(float ang, float& c, float& s) {
    const double x = (double)ang;
    const double n = rint(x * 0.63661977236758134308);
    double r = fma(-n, 1.57079632673412561417e+00, x);
    r = fma(-n, 6.07710050650619224932e-11, r);
    const double r2 = r * r;
    double sp = 1.0 / 6227020800.0;
    sp = fma(sp, r2, -1.0 / 39916800.0); sp = fma(sp, r2, 1.0 / 362880.0); sp = fma(sp, r2, -1.0 / 5040.0);
    sp = fma(sp, r2, 1.0 / 120.0); sp = fma(sp, r2, -1.0 / 6.0); sp = fma(sp, r2, 1.0);
    const double sr = sp * r;
    double cp = -1.0 / 87178291200.0;
    cp = fma(cp, r2, 1.0 / 479001600.0); cp = fma(cp, r2, -1.0 / 3628800.0); cp = fma(cp, r2, 1.0 / 40320.0);
    cp = fma(cp, r2, -1.0 / 720.0); cp = fma(cp, r2, 1.0 / 24.0); cp = fma(cp, r2, -0.5); cp = fma(cp, r2, 1.0);
    const int q = ((int)n) & 3;
    const double ss = (q == 0) ? sr : (q == 1) ? cp : (q == 2) ? -sr : -cp;
    const double cc = (q == 0) ? cp : (q == 1) ? -sr : (q == 2) ? -cp : sr;
    c = (float)cc; s = (float)ss;
}
DI void phase_tables(const P& p) {
    const int tid_ = tid();
    char* ws_ = launder(p.ws);
    float2* tab = (float2*)(ws_ + OFF_TAB);
    const int total = 160 * 8192;
    for (int idx = blockIdx.x * 512 + tid_; idx < total; idx += gridDim.x * 512) {
        const int row = idx >> 13, t = idx & 8191;
        float inv, pos;
        if (row < 128) { const float frac = (float)row / 127.0f; inv = (float)exp(-9.210340371976184 * (double)frac); pos = (float)t; }
        else { const int j = (row - 128) & 15; inv = (float)exp(-9.210340371976184 * ((double)j / 16.0)); pos = (row < 144) ? (float)(t >> 6) : (float)(t & 63); }
        const float ang = pos * inv;
        float c, s; sincos_tab(ang, c, s);
        tab[idx] = make_float2(c, s);
    }
}
DI void phase_misc(const P& p) {
    const int tid_ = tid();
    char* ws_ = launder(p.ws);
    if (blockIdx.x == 0) {
        float* misc = (float*)(ws_ + OFF_MISC);
        const int t = tid_;
        if (t < 16) {
            const int l = t >> 3, dir = (t >> 2) & 1, h = t & 3;
            const double xx = (double)(dir ? p.dec_b : p.dec_f)[l * 4 + h];
            const double lg = (xx > 0.0) ? -log1p(exp(-xx)) : (xx - log1p(exp(xx)));
            misc[8 + l * 8 + dir * 4 + h] = (float)(lg * 1.4426950408889634);
        } else if (t < 18) {
            const int l = t - 16;
            float s1 = 0.f, s2 = 0.f;
            for (int i = 0; i < 64; ++i) { s1 += p.lq1[l * 64 + i] * p.lk1[l * 64 + i]; s2 += p.lq2[l * 64 + i] * p.lk2[l * 64 + i]; }
            const float lam_init = 0.8f - 0.6f * expf(-0.3f * (float)l);
            misc[l] = expf(s1) - expf(s2) + lam_init;
        }
    }
}
DI void phase_mod(const P& p, char* smem) {
    const int tid_ = tid();
    char* ws_ = launder(p.ws);
    float* sc = (float*)smem;
    float* red = (float*)(smem + 20480);
    float* mod = (float*)(ws_ + OFF_MOD);
    const int t = tid_, nn = t & 63, kg = t >> 6;
    for (int idx = blockIdx.x; idx < 192; idx += gridDim.x) {
        const int l = idx / 96, nc = idx % 96, n = nc * 64 + nn;
        __syncthreads();
        for (int i = t; i < 5120; i += 512) { const int r = i >> 10, k = i & 1023; const float v = (r < 4) ? p.c[r * 1024 + k] : p.c_ctx[k]; sc[i] = v * sigmoidf_(v); }
        __syncthreads();
        float a[5] = {0.f, 0.f, 0.f, 0.f, 0.f};
        const float* wp = p.w_mod + (size_t)l * 1024 * 6144 + n;
        for (int k = kg; k < 1024; k += 8) {
            const float wv = wp[(size_t)k * 6144];
#pragma unroll
            for (int r = 0; r < 5; ++r) a[r] += sc[r * 1024 + k] * wv;
        }
#pragma unroll
        for (int r = 0; r < 5; ++r) red[(kg * 5 + r) * 64 + nn] = a[r];
        __syncthreads();
        if (kg == 0) {
#pragma unroll
            for (int r = 0; r < 5; ++r) {
                float s = 0.f;
                for (int g8 = 0; g8 < 8; ++g8) s += red[(g8 * 5 + r) * 64 + nn];
                mod[((size_t)l * 5 + r) * 6144 + n] = s + p.b_mod[l * 6144 + n];
            }
        }
    }
}

DI void ln_stats(const float (&v)[16], float& mean, float& rstd, float eps) {
    float s = 0.f;
#pragma unroll
    for (int i = 0; i < 16; ++i) s += v[i];
    s = wave_sum(s); mean = s * (1.f / 1024.f);
    float q = 0.f;
#pragma unroll
    for (int i = 0; i < 16; ++i) { const float d = v[i] - mean; q += d * d; }
    q = wave_sum(q); rstd = rsqrtf(q * (1.f / 1024.f) + eps);
}
DI void load16(const float* p, int lane, float (&v)[16]) {
#pragma unroll
    for (int i = 0; i < 4; ++i) { const float4 a = *(const float4*)(p + 4 * (lane + 64 * i)); v[4 * i] = a.x; v[4 * i + 1] = a.y; v[4 * i + 2] = a.z; v[4 * i + 3] = a.w; }
}
DI void store16(float* p, int lane, const float (&v)[16]) {
#pragma unroll
    for (int i = 0; i < 4; ++i) *(float4*)(p + 4 * (lane + 64 * i)) = make_float4(v[4 * i], v[4 * i + 1], v[4 * i + 2], v[4 * i + 3]);
}
DI void store16_bf(bf16_t* p, int lane, const float (&v)[16]) {
#pragma unroll
    for (int i = 0; i < 4; ++i) { uint2 u; u.x = pack2(v[4 * i], v[4 * i + 1]); u.y = pack2(v[4 * i + 2], v[4 * i + 3]); *(uint2*)(p + 4 * (lane + 64 * i)) = u; }
}
DI const float* in_row(const P& p, int b, int r) { return (r < SEQ) ? p.x + ((size_t)b * SEQ + r) * D : p.ctx + ((size_t)b * CTXL + (r - SEQ)) * D; }
DI float* xs_row(const P& p, int b, int r) { return (r < SEQ) ? p.out + ((size_t)b * SEQ + r) * D : (float*)(p.ws + OFF_XC) + ((size_t)b * CTXL + (r - SEQ)) * D; }

DI void phase_lnmod0(const P& p) {
    const int tid_ = tid();
    char* ws_ = launder(p.ws);
    const int lane = tid_ & 63, wv = tid_ >> 6;
    const float* mod = (const float*)(ws_ + OFF_MOD);
    bf16_t* H = (bf16_t*)(ws_ + OFF_H);
    for (int row = blockIdx.x * 8 + wv; row < NBATCH * RB; row += gridDim.x * 8) {
        const int b = row / RB, r = row % RB, mi = (r < SEQ) ? b : 4;
        float v[16], sh[16], sc[16]; load16(in_row(p, b, r), lane, v);
        float mean, rstd; ln_stats(v, mean, rstd, 1e-6f);
        load16(mod + (size_t)mi * 6144 + 0 * 1024, lane, sh); load16(mod + (size_t)mi * 6144 + 1 * 1024, lane, sc);
#pragma unroll
        for (int i = 0; i < 16; ++i) v[i] = (v[i] - mean) * rstd * (1.f + sc[i]) + sh[i];
        store16_bf(H + (size_t)row * HLD, lane, v);
    }
}
DI void phase_ln1(const P& p, int l, int b, int nrows, int cmode) {
    const int tid_ = tid();
    char* ws_ = launder(p.ws);
    const int lane = tid_ & 63, wv = tid_ >> 6;
    const float* mod = (const float*)(ws_ + OFF_MOD) + (size_t)l * 5 * 6144;
    const float* Y = (const float*)(ws_ + OFF_ST);
    bf16_t* H = (bf16_t*)(ws_ + OFF_H);
    const float alpha = 1.4142135623730951f;
    for (int r = blockIdx.x * 8 + wv; r < nrows; r += gridDim.x * 8) {
        const int bb = cmode ? (r >> 8) : b, rr = cmode ? SEQ + (r & 255) : r;
        const int mi = (rr < SEQ) ? bb : 4;
        float v[16], y[16], g[16], lg[16], lb[16], sh[16], sc[16];
        load16(l == 0 ? in_row(p, bb, rr) : xs_row(p, bb, rr), lane, v);
        load16(Y + (size_t)r * D, lane, y); load16(mod + (size_t)mi * 6144 + 2 * 1024, lane, g);
        load16(p.ln1_g + l * 1024, lane, lg); load16(p.ln1_b + l * 1024, lane, lb);
        load16(mod + (size_t)mi * 6144 + 3 * 1024, lane, sh); load16(mod + (size_t)mi * 6144 + 4 * 1024, lane, sc);
#pragma unroll
        for (int i = 0; i < 16; ++i) v[i] = alpha * v[i] + g[i] * y[i];
        float mean, rstd; ln_stats(v, mean, rstd, 1e-6f);
#pragma unroll
        for (int i = 0; i < 16; ++i) v[i] = (v[i] - mean) * rstd * lg[i] + lb[i];
        store16(xs_row(p, bb, rr), lane, v);
        ln_stats(v, mean, rstd, 1e-6f);
#pragma unroll
        for (int i = 0; i < 16; ++i) v[i] = (v[i] - mean) * rstd * (1.f + sc[i]) + sh[i];
        store16_bf(cmode ? (bf16_t*)(ws_ + OFF_KT + (4u << 20)) + (size_t)r * HLD : H + ((size_t)b * RB + r) * HLD, lane, v);
    }
}
DI void phase_ln2(const P& p, int l, int b, int nrows, int cmode) {
    const int tid_ = tid();
    char* ws_ = launder(p.ws);
    const int lane = tid_ & 63, wv = tid_ >> 6;
    const float* mod = (const float*)(ws_ + OFF_MOD) + (size_t)l * 5 * 6144;
    const float* modn = (const float*)(ws_ + OFF_MOD) + (size_t)1 * 5 * 6144;
    const float* Y2 = (const float*)(ws_ + OFF_ST);
    bf16_t* H = (bf16_t*)(ws_ + OFF_H);
    const float alpha = 1.4142135623730951f;
    for (int r = blockIdx.x * 8 + wv; r < nrows; r += gridDim.x * 8) {
        const int bb = cmode ? (r >> 8) : b, rr = cmode ? SEQ + (r & 255) : r;
        const int mi = (rr < SEQ) ? bb : 4;
        float v[16], y[16], g[16], lg[16], lb[16], sh[16], sc[16];
        load16(xs_row(p, bb, rr), lane, v);
        load16(Y2 + (size_t)r * D, lane, y); load16(mod + (size_t)mi * 6144 + 5 * 1024, lane, g);
        load16(p.ln2_g + l * 1024, lane, lg); load16(p.ln2_b + l * 1024, lane, lb);
        if (l == 0) { load16(modn + (size_t)mi * 6144 + 0 * 1024, lane, sh); load16(modn + (size_t)mi * 6144 + 1 * 1024, lane, sc); }
#pragma unroll
        for (int i = 0; i < 16; ++i) v[i] = alpha * v[i] + g[i] * y[i];
        float mean, rstd; ln_stats(v, mean, rstd, 1e-6f);
#pragma unroll
        for (int i = 0; i < 16; ++i) v[i] = (v[i] - mean) * rstd * lg[i] + lb[i];
        store16(xs_row(p, bb, rr), lane, v);
        if (l == 0) {
            ln_stats(v, mean, rstd, 1e-6f);
#pragma unroll
            for (int i = 0; i < 16; ++i) v[i] = (v[i] - mean) * rstd * (1.f + sc[i]) + sh[i];
            store16_bf(H + ((size_t)bb * RB + rr) * HLD, lane, v);
        }
    }
}

DI void phase_inproj(const P& p, int l, int b, char* smem) {
    const int tid_ = tid();
    char* ws_ = launder(p.ws);
    const bf16_t* Hb = (const bf16_t*)(ws_ + OFF_H) + (size_t)b * RB * HLD;
    const bf16_t* W = (const bf16_t*)(ws_ + OFF_WIN);
    bf16_t* Z = (bf16_t*)(ws_ + OFF_Z);
    bf16_t* VT = (bf16_t*)(ws_ + OFF_VT);
    bf16_t* KT = (bf16_t*)(ws_ + OFF_KT);
    const float2* tab = (const float2*)(ws_ + OFF_TAB);
    const float* misc = (const float*)(ws_ + OFF_MISC);
    const int t = tid_, w = t >> 6, ln = t & 63, lr = ln & 31, lh = ln >> 5, wm = w >> 2, wn = w & 3;
    const int NTN = INW / 256, NTM = RB / 256;
    for (int idx = blockIdx.x; idx < NTM * NTN; idx += gridDim.x) {
        const int tn = idx % NTN, tm = idx / NTN, m0 = tm * 256, n0 = tn * 256, grp = n0 >> 10;
        f32x16 acc[4][2]; zero4(acc);
        if (grp >= 10) {
            gemm_kloop<false>(Hb + (size_t)m0 * HLD, HLD, W + (size_t)n0 * WK, WK, D, acc, smem);
#pragma unroll
            for (int i = 0; i < 4; ++i)
#pragma unroll
                for (int j = 0; j < 2; ++j) {
                    const int n = n0 + 64 * wn + 32 * j + lr, mb = m0 + 128 * wm + 32 * i + 4 * lh;
                    bf16_t* dst = VT + (size_t)(n - 10240) * VLD + mb;
#pragma unroll
                    for (int q = 0; q < 4; ++q) {
                        uint2 v; v.x = pack2(acc[i][j][4 * q], acc[i][j][4 * q + 1]); v.y = pack2(acc[i][j][4 * q + 2], acc[i][j][4 * q + 3]);
                        *(uint2*)(dst + 8 * q) = v;
                    }
                }
        } else {
            gemm_kloop<true>(Hb + (size_t)m0 * HLD, HLD, W + (size_t)n0 * WK, WK, D, acc, smem);
#pragma unroll
            for (int i = 0; i < 4; ++i) {
                const int m = m0 + 128 * wm + 32 * i + lr;
                const bool lat = m < SEQ;
#pragma unroll
                for (int j = 0; j < 2; ++j) {
                    const int nb = n0 + 64 * wn + 32 * j;
                    f32x16& a = acc[i][j];
                    if (grp == 0 || grp == 1 || grp == 3 || grp == 4) {
                        if (lat) {
#pragma unroll
                            for (int g2 = 0; g2 < 2; ++g2)
#pragma unroll
                                for (int e = 0; e < 4; ++e) {
                                    int trow;
                                    if (grp < 2) { const int G = ((nb & 255) >> 4) + g2; trow = 8 * G + e + 4 * lh; }
                                    else { const int G = ((nb & 63) >> 4) + g2; trow = 128 + 16 * (G >> 1) + 8 * (G & 1) + e + 4 * lh; }
                                    const float2 cs = tab[(size_t)trow * 8192 + m];
                                    const float x1 = a[8 * g2 + e], x2 = a[8 * g2 + e + 4];
                                    a[8 * g2 + e] = x1 * cs.x - x2 * cs.y;
                                    a[8 * g2 + e + 4] = x1 * cs.y + x2 * cs.x;
                                }
                        }
                        const float sc = (grp == 1) ? 0.0625f : (grp == 3) ? 0.125f * L2E : 1.f;
#pragma unroll
                        for (int e = 0; e < 16; ++e) a[e] *= sc;
                    } else if (grp == 5) {
#pragma unroll
                        for (int e = 0; e < 16; ++e) a[e] *= 0.125f * L2E;
                    } else if (grp >= 7) {
#pragma unroll
                        for (int e = 0; e < 16; ++e) a[e] = sigmoidf_(a[e]);
                    }
                    bf16_t* dst = Z + (size_t)m * ZLD + nb + 4 * lh;
#pragma unroll
                    for (int q = 0; q < 4; ++q) {
                        uint2 v; v.x = pack2(a[4 * q], a[4 * q + 1]); v.y = pack2(a[4 * q + 2], a[4 * q + 3]);
                        *(uint2*)(dst + 8 * q) = v;
                    }
                    if (grp == 1) {
                        const int h4 = (nb - 1024) >> 8;
                        const int ic = (lat ? m : m - SEQ) & 255;
                        const float df = exp2f(misc[8 + l * 8 + 0 + h4] * (float)(255 - ic));
                        const float db = exp2f(misc[8 + l * 8 + 4 + h4] * (float)ic);
#pragma unroll
                        for (int e = 0; e < 16; ++e) {
                            const int n = nb + (e & 3) + 8 * (e >> 2) + 4 * lh - 1024;
                            KT[(size_t)n * VLD + m] = f2bf(a[e] * df);
                            KT[(size_t)(1024 + n) * VLD + m] = f2bf(a[e] * db);
                        }
                    }
                }
            }
        }
    }
}

struct NoMask {
    DI bool active(int) const { return true; }
    DI void apply(int, f32x16 (&)[2], int) const {}
};
struct NaMask {
    int r, rs, j, cs; const float* rpb;
    DI bool active(int kt) const { return kt >= 128 || (kt >= rs && kt < rs + 8); }
    DI void apply(int kt, f32x16 (&st)[2], int lh) const {
        if (kt < 128) {
            const float* bl = rpb + (kt - r + 7) * 31 + (4 * lh - j + 15);
            const int c0 = 4 * lh - cs;
#pragma unroll
            for (int kk = 0; kk < 2; ++kk)
#pragma unroll
                for (int e = 0; e < 16; ++e) {
                    const int kce = 32 * kk + (e & 3) + 8 * (e >> 2);
                    const bool ok = (unsigned)(kce + c0) < 16u;
                    st[kk][e] = ok ? st[kk][e] + bl[kce] : -1e30f;
                }
        }
    }
};
template <int DV, class MaskF>
DI void flash_core(const bf16_t* __restrict__ zq, const bf16_t* __restrict__ zk, const bf16_t* __restrict__ vt,
                   int t1s, int t1n, int t2s, int t2n, const MaskF& mf, f32x16 (&ot)[DV / 32], char* smem) {
    const int tid_ = tid();
    constexpr int ND = DV / 32;
    const int t = tid_, w = t >> 6, l = t & 63, lr = l & 31, lh = l >> 5;
    bf16_t(*sq)[72] = (bf16_t(*)[72])(smem + 57344);
#pragma unroll
    for (int d = 0; d < ND; ++d)
#pragma unroll
        for (int e = 0; e < 16; ++e) ot[d][e] = 0.f;
    float mrun = 0.f, lrun = 0.f;
#if FOLD_M
    bf16x8 kone, qm;
    { union { bf16x8 v; unsigned u[4]; } kk_; kk_.u[0] = (lh == 0) ? 0x3f80u : 0u; kk_.u[1] = 0u; kk_.u[2] = 0u; kk_.u[3] = 0u; kone = kk_.v; kk_.u[0] = 0u; qm = kk_.v; }
#endif
    const int nt = t1n + t2n;
    const int crow_ = t >> 3, cc = t & 7;
    const int plo = 16 * (cc >> 1) + 4 * (cc & 1);
    constexpr int NV = DV / 64;
    u32x4 kreg, vreg[NV];
#define FC_TILE(IT) (((IT) < t1n) ? (t1s + (IT)) : (t2s + (IT) - t1n))
#define FC_PREFETCH(KT) do { const int kt_ = (KT); \
        kreg = *(const u32x4*)(zk + (size_t)(64 * kt_ + crow_) * ZLD + cc * 8); \
        _Pragma("unroll") for (int i = 0; i < NV; ++i) vreg[i] = *(const u32x4*)(vt + (size_t)(crow_ + 64 * i) * VLD + 64 * kt_ + cc * 8); } while (0)
#define FC_STORE(BUF) do { bf16_t(*sk_)[72] = (bf16_t(*)[72])(smem + (BUF) * 27648); bf16_t(*sv_)[72] = (bf16_t(*)[72])(smem + (BUF) * 27648 + 64 * 144); \
        *(u32x4*)&sk_[crow_][cc * 8] = kreg; \
        _Pragma("unroll") for (int i = 0; i < NV; ++i) { u32x2 lo_, hi_; lo_.x = vreg[i].x; lo_.y = vreg[i].y; hi_.x = vreg[i].z; hi_.y = vreg[i].w; \
            *(u32x2*)&sv_[crow_ + 64 * i][plo] = lo_; *(u32x2*)&sv_[crow_ + 64 * i][plo + 8] = hi_; } } while (0)
    __syncthreads();
    {
#pragma unroll
        for (int i = 0; i < 4; ++i) { const u32x4 qv = *(const u32x4*)(zq + (size_t)(crow_ + 64 * i) * ZLD + cc * 8); *(u32x4*)&sq[crow_ + 64 * i][cc * 8] = qv; }
    }
    FC_PREFETCH(FC_TILE(0));
    FC_STORE(0);
    if (nt > 1) FC_PREFETCH(FC_TILE(1));
    __syncthreads();
    for (int it = 0; it < nt; ++it) {
        const int kt = FC_TILE(it);
        if (it + 1 < nt) FC_STORE((it + 1) & 1);
        if (it + 2 < nt) FC_PREFETCH(FC_TILE(it + 2));
        if (mf.active(kt)) {
            const bf16_t(*sk)[72] = (const bf16_t(*)[72])(smem + (it & 1) * 27648);
            const bf16_t(*sv)[72] = (const bf16_t(*)[72])(smem + (it & 1) * 27648 + 64 * 144);
            f32x16 st[2];
#pragma unroll
            for (int kk = 0; kk < 2; ++kk)
#pragma unroll
                for (int e = 0; e < 16; ++e) st[kk][e] = 0.f;
#pragma unroll
            for (int s = 0; s < 4; ++s) {
                const bf16x8 qfs = *(const bf16x8*)&sq[32 * w + lr][16 * s + 8 * lh];
#pragma unroll
                for (int kk = 0; kk < 2; ++kk) {
                    const bf16x8 kf = *(const bf16x8*)&sk[32 * kk + lr][16 * s + 8 * lh];
                    st[kk] = MFMA(kf, qfs, st[kk]);
                }
            }
#if FOLD_M
#pragma unroll
            for (int kk = 0; kk < 2; ++kk) st[kk] = MFMA(kone, qm, st[kk]);
#endif
            mf.apply(kt, st, lh);
            union { bf16x8 v; unsigned u[4]; } pf[4];
            float ps = 0.f;
#pragma unroll
            for (int s2 = 0; s2 < 4; ++s2)
#pragma unroll
                for (int q = 0; q < 4; ++q) {
                    const int kk = s2 >> 1, e = 8 * (s2 & 1) + 2 * q;
#if FOLD_M
                    const float p0 = __builtin_amdgcn_exp2f(st[kk][e]), p1 = __builtin_amdgcn_exp2f(st[kk][e + 1]);
#else
                    const float p0 = __builtin_amdgcn_exp2f(st[kk][e] - mrun), p1 = __builtin_amdgcn_exp2f(st[kk][e + 1] - mrun);
#endif
                    ps += p0; ps += p1; pf[s2].u[q] = pack2(p0, p1);
                }
            if (__any(!(ps <= 65536.f) || ps < 7.9e-31f)) {
                float mx = st[0][0];
#pragma unroll
                for (int kk = 0; kk < 2; ++kk)
#pragma unroll
                    for (int e = 0; e < 16; e += 2) mx = fmaxf(fmaxf(mx, st[kk][e]), st[kk][e + 1]);
                mx = fmaxf(mx, __shfl_xor(mx, 32));
                float delta = 0.f;
#if FOLD_M
                if (mx > -1e29f) { const float mn = __uint_as_float(pack2(mrun + mx, 0.f) << 16); delta = mn - mrun; mrun = mn; }
                const float sub = delta;
                { union { bf16x8 v; unsigned u[4]; } qq; qq.u[0] = (lh == 0) ? (pack2(-mrun, 0.f) & 0xffffu) : 0u; qq.u[1] = 0u; qq.u[2] = 0u; qq.u[3] = 0u; qm = qq.v; }
#else
                if (mx > -1e29f) { delta = mx - mrun; mrun = mx; }
                const float sub = mrun;
#endif
                const float alpha = __builtin_amdgcn_exp2f(-delta);
                lrun *= alpha;
#pragma unroll
                for (int d = 0; d < ND; ++d)
#pragma unroll
                    for (int e = 0; e < 16; ++e) ot[d][e] *= alpha;
                ps = 0.f;
#pragma unroll
                for (int s2 = 0; s2 < 4; ++s2)
#pragma unroll
                    for (int q = 0; q < 4; ++q) {
                        const int kk = s2 >> 1, e = 8 * (s2 & 1) + 2 * q;
                        const float p0 = __builtin_amdgcn_exp2f(st[kk][e] - sub), p1 = __builtin_amdgcn_exp2f(st[kk][e + 1] - sub);
                        ps += p0; ps += p1; pf[s2].u[q] = pack2(p0, p1);
                    }
            }
            lrun += ps;
#pragma unroll
            for (int s2 = 0; s2 < 4; ++s2)
#pragma unroll
                for (int d = 0; d < ND; ++d) {
                    const bf16x8 vf = *(const bf16x8*)&sv[32 * d + lr][16 * s2 + 8 * lh];
                    ot[d] = MFMA(vf, pf[s2].v, ot[d]);
                }
        }
        __syncthreads();
    }
#undef FC_TILE
#undef FC_PREFETCH
#undef FC_STORE
    const float ltot = lrun + __shfl_xor(lrun, 32);
    const float inv = 1.f / ltot;
#pragma unroll
    for (int d = 0; d < ND; ++d)
#pragma unroll
        for (int e = 0; e < 16; ++e) ot[d][e] *= inv;
}

DI void diff_item(const P& p, int l, int b, int h8, int qb, char* smem) {
    const int tid_ = tid();
    char* ws_ = launder(p.ws);
    const bf16_t* Z = (const bf16_t*)(ws_ + OFF_Z);
    const bf16_t* VT = (const bf16_t*)(ws_ + OFF_VT);
    bf16_t* OD = (bf16_t*)(ws_ + OFF_O) + (size_t)1 * RB * OLD;
    const float* misc = (const float*)(ws_ + OFF_MISC);
    const int t = tid_, w = t >> 6, ln = t & 63, lr = ln & 31, lh = ln >> 5;
    const int qrow0 = 256 * qb;
    const int t1s = (qb < 32) ? 0 : 128, t1n = (qb < 32) ? 132 : 4;
    f32x16 o0[4];
    NoMask nm;
    const int item_ = h8 + 8 * qb;
    float* dsc = (float*)(ws_ + (item_ < 132 ? OFF_H + (size_t)b * RB * HLD * 2 : OFF_O)) + (size_t)(item_ < 132 ? item_ : item_ - 132) * 32768 + t * 4;
    flash_core<128>(Z + (size_t)qrow0 * ZLD + ZC_DQ + h8 * 128 + 64, Z + ZC_DK + h8 * 128 + 64, VT + (size_t)(1024 + h8 * 128) * VLD, t1s, t1n, 0, 0, nm, o0, smem);
#pragma unroll
    for (int d = 0; d < 4; ++d)
#pragma unroll
        for (int q = 0; q < 4; ++q) *(float4*)(dsc + (size_t)(d * 4 + q) * 2048) = make_float4(o0[d][4 * q], o0[d][4 * q + 1], o0[d][4 * q + 2], o0[d][4 * q + 3]);
    flash_core<128>(Z + (size_t)qrow0 * ZLD + ZC_DQ + h8 * 128, Z + ZC_DK + h8 * 128, VT + (size_t)(1024 + h8 * 128) * VLD, t1s, t1n, 0, 0, nm, o0, smem);
    const float lam = misc[l];
    const float lam_init = 0.8f - 0.6f * expf(-0.3f * (float)l);
    float ss = 0.f;
#pragma unroll
    for (int d = 0; d < 4; ++d)
#pragma unroll
        for (int q = 0; q < 4; ++q) {
            const float4 o1 = *(const float4*)(dsc + (size_t)(d * 4 + q) * 2048);
            float v;
            v = o0[d][4 * q] - lam * o1.x; o0[d][4 * q] = v; ss += v * v;
            v = o0[d][4 * q + 1] - lam * o1.y; o0[d][4 * q + 1] = v; ss += v * v;
            v = o0[d][4 * q + 2] - lam * o1.z; o0[d][4 * q + 2] = v; ss += v * v;
            v = o0[d][4 * q + 3] - lam * o1.w; o0[d][4 * q + 3] = v; ss += v * v;
        }
    ss += __shfl_xor(ss, 32);
    const float rinv = rsqrtf(ss * (1.f / 128.f) + 1e-5f) * (1.f - lam_init);
    const int row = qrow0 + 32 * w + lr;
    const float* g = p.subln_g + l * 128;
#pragma unroll
    for (int d = 0; d < 4; ++d)
#pragma unroll
        for (int q = 0; q < 4; ++q) {
            const int dv = 32 * d + 8 * q + 4 * lh;
            const float4 gv = *(const float4*)(g + dv);
            uint2 v; v.x = pack2(o0[d][4 * q] * rinv * gv.x, o0[d][4 * q + 1] * rinv * gv.y); v.y = pack2(o0[d][4 * q + 2] * rinv * gv.z, o0[d][4 * q + 3] * rinv * gv.w);
            *(uint2*)(OD + (size_t)row * OLD + h8 * 128 + dv) = v;
        }
}
DI void na_item(const P& p, int l, int h16, int it, char* smem) {
    const int tid_ = tid();
    char* ws_ = launder(p.ws);
    const bf16_t* Z = (const bf16_t*)(ws_ + OFF_Z);
    const bf16_t* VT = (const bf16_t*)(ws_ + OFF_VT);
    bf16_t* ON = (bf16_t*)(ws_ + OFF_O) + (size_t)2 * RB * OLD;
    const int t = tid_, w = t >> 6, ln = t & 63, lr = ln & 31, lh = ln >> 5;
    const int qrow0 = 256 * it;
    f32x16 o[2];
    const bf16_t* zq = Z + (size_t)qrow0 * ZLD + ZC_NQ + h16 * 64;
    const bf16_t* zk = Z + ZC_NK + h16 * 64;
    const bf16_t* vt = VT + (size_t)(2048 + h16 * 64) * VLD;
    if (it < 32) {
        float* rp = (float*)(smem + 2 * 27648);
        __syncthreads();
        for (int i = t; i < 465; i += 512) rp[i] = p.rpb[((size_t)l * 16 + h16) * 465 + i] * L2E;
        const int r0 = 4 * it, r1 = r0 + 3;
        const int rs0 = min(max(r0 - 4, 0), 120), rs1 = min(max(r1 - 4, 0), 120);
        NaMask mk;
        mk.r = r0 + (w >> 1); mk.rs = min(max(mk.r - 4, 0), 120);
        mk.j = 32 * (w & 1) + lr; mk.cs = min(max(mk.j - 8, 0), 48); mk.rpb = rp;
        flash_core<64>(zq, zk, vt, rs0, rs1 + 8 - rs0, 128, 4, mk, o, smem);
    } else {
        NoMask nm;
        flash_core<64>(zq, zk, vt, 128, 4, 0, 0, nm, o, smem);
    }
    const int row = qrow0 + 32 * w + lr;
#pragma unroll
    for (int d = 0; d < 2; ++d)
#pragma unroll
        for (int q = 0; q < 4; ++q) {
            const int dv = 32 * d + 8 * q + 4 * lh;
            uint2 v; v.x = pack2(o[d][4 * q], o[d][4 * q + 1]); v.y = pack2(o[d][4 * q + 2], o[d][4 * q + 3]);
            *(uint2*)(ON + (size_t)row * OLD + h16 * 64 + dv) = v;
        }
}

DI int tb_rowbase(int TB) { return TB == 0 ? SEQ : 256 * (TB - 1); }
DI void r1_tile(const P& p, int idx, char* smem) {
    char* ws_ = launder(p.ws);
    const int n = idx & 31, dir = (idx >> 5) & 1, h4 = idx >> 6;
    const int TB = (dir == 0) ? n : (n == 0 ? 0 : 33 - n);
    const int rb = tb_rowbase(TB);
    const bf16_t* A = (const bf16_t*)(ws_ + OFF_VT) + (size_t)(h4 * 256) * VLD + rb;
    const bf16_t* B = (const bf16_t*)(ws_ + OFF_KT) + (size_t)(dir * 1024 + h4 * 256) * VLD + rb;
    bf16_t* C = (bf16_t*)(ws_ + OFF_ST) + ((size_t)(h4 * 2 + dir) * 32 + n) * 65536;
    f32x16 acc[4][2]; zero4(acc);
    gemm_kloop<true>(A, VLD, B, VLD, 256, acc, smem);
    store_swap_bf16(acc, C, 256, 0, 0);
}
DI void r3a_tile(const P& p, int l, int h4, int TB, char* smem) {
    const int tid_ = tid();
    char* ws_ = launder(p.ws);
    const int rb = tb_rowbase(TB);
    const bf16_t* Z = (const bf16_t*)(ws_ + OFF_Z);
    const float* misc = (const float*)(ws_ + OFF_MISC);
    bf16_t* C = (bf16_t*)(ws_ + OFF_ATT) + (size_t)(h4 * 33 + TB) * 65536;
    f32x16 acc[4][2]; zero4(acc);
    gemm_kloop<true>(Z + (size_t)rb * ZLD + ZC_RQ + h4 * 256, ZLD, Z + (size_t)rb * ZLD + ZC_RK + h4 * 256, ZLD, 256, acc, smem);
    const float lgf = misc[8 + l * 8 + h4], lgb = misc[8 + l * 8 + 4 + h4];
    const int t = tid_, w = t >> 6, ln = t & 63, lr = ln & 31, lh = ln >> 5, wm = w >> 2, wn = w & 3;
#pragma unroll
    for (int i = 0; i < 4; ++i)
#pragma unroll
        for (int j = 0; j < 2; ++j) {
            const int qi = 128 * wm + 32 * i + lr;
#pragma unroll
            for (int e = 0; e < 16; ++e) {
                const int kj = 64 * wn + 32 * j + (e & 3) + 8 * (e >> 2) + 4 * lh;
                const int dd = qi - kj;
                const float wf = (dd >= 0) ? __builtin_amdgcn_exp2f(lgf * (float)dd) : 0.f;
                const float wb = (dd <= 0) ? __builtin_amdgcn_exp2f(lgb * (float)(-dd)) : 0.f;
                acc[i][j][e] *= (wf + wb);
            }
        }
    store_swap_bf16(acc, C, 256, 0, 0);
}
DI void r3b_tile(const P& p, int l, int h4, int TB, int mh, char* smem) {
    const int tid_ = tid();
    char* ws_ = launder(p.ws);
    const int rb = tb_rowbase(TB);
    const bf16_t* Z = (const bf16_t*)(ws_ + OFF_Z);
    const bf16_t* VT = (const bf16_t*)(ws_ + OFF_VT);
    const bf16_t* ST = (const bf16_t*)(ws_ + OFF_ST);
    const bf16_t* ATT = (const bf16_t*)(ws_ + OFF_ATT) + (size_t)(h4 * 33 + TB) * 65536 + (size_t)(128 * mh) * 256;
    bf16_t* OR = (bf16_t*)(ws_ + OFF_O);
    const float* misc = (const float*)(ws_ + OFF_MISC);
    const int t = tid_, w = t >> 6, ln = t & 63, lr = ln & 31, lh = ln >> 5, wm = w >> 2, wn = w & 3;
    f32x16 acc[2][2];
    zero4(acc);
    if (TB >= 1) {
        const int nf = TB, nb = 33 - TB;
        const bf16_t* Aq = Z + (size_t)(rb + 128 * mh) * ZLD + ZC_RQ + h4 * 256;
        const float lgf = misc[8 + l * 8 + h4], lgb = misc[8 + l * 8 + 4 + h4];
        gemm_kloop<true, 2>(Aq, ZLD, ST + ((size_t)(h4 * 2 + 1) * 32 + (nb - 1)) * 65536, 256, 256, acc, smem);
#pragma unroll
        for (int i = 0; i < 2; ++i) {
            const int qi = 128 * mh + 64 * wm + 32 * i + lr;
            const float ratio = exp2f(lgb * (float)(256 - qi) - lgf * (float)(qi + 1));
#pragma unroll
            for (int j = 0; j < 2; ++j)
#pragma unroll
                for (int e = 0; e < 16; ++e) acc[i][j][e] *= ratio;
        }
        gemm_kloop<true, 2>(Aq, ZLD, ST + ((size_t)(h4 * 2 + 0) * 32 + (nf - 1)) * 65536, 256, 256, acc, smem);
#pragma unroll
        for (int i = 0; i < 2; ++i) {
            const int qi = 128 * mh + 64 * wm + 32 * i + lr;
            const float sf = exp2f(lgf * (float)(qi + 1));
#pragma unroll
            for (int j = 0; j < 2; ++j)
#pragma unroll
                for (int e = 0; e < 16; ++e) acc[i][j][e] *= sf;
        }
    }
    gemm_kloop<true, 2>(ATT, 256, VT + (size_t)(h4 * 256) * VLD + rb, VLD, 256, acc, smem);
    {
        float2* red = (float2*)smem;
        float s1[2], s2[2];
#pragma unroll
        for (int i = 0; i < 2; ++i) {
            float a = 0.f, q = 0.f;
#pragma unroll
            for (int j = 0; j < 2; ++j)
#pragma unroll
                for (int e = 0; e < 16; ++e) { const float x = acc[i][j][e]; a += x; q += x * x; }
            a += __shfl_xor(a, 32); q += __shfl_xor(q, 32);
            if (lh == 0) red[(64 * wm + 32 * i + lr) * 4 + wn] = make_float2(a, q);
        }
        __syncthreads();
#pragma unroll
        for (int i = 0; i < 2; ++i) {
            const int row = 64 * wm + 32 * i + lr;
            const float2 r0 = red[row * 4 + 0], r1 = red[row * 4 + 1], r2 = red[row * 4 + 2], r3 = red[row * 4 + 3];
            const float mean = (r0.x + r1.x + r2.x + r3.x) * (1.f / 256.f);
            const float var = (r0.y + r1.y + r2.y + r3.y) * (1.f / 256.f) - mean * mean;
            s1[i] = mean; s2[i] = rsqrtf(fmaxf(var, 0.f) + 1e-6f);
        }
#pragma unroll
        for (int i = 0; i < 2; ++i)
#pragma unroll
            for (int j = 0; j < 2; ++j) {
                const int row = rb + 128 * mh + 64 * wm + 32 * i + lr, nb = 64 * wn + 32 * j + 4 * lh;
                const bf16_t* gp = Z + (size_t)row * ZLD + ZC_RG + h4 * 256 + nb;
                bf16_t* op = OR + (size_t)row * OLD + h4 * 256 + nb;
#pragma unroll
                for (int q = 0; q < 4; ++q) {
                    const u32x2 gv = *(const u32x2*)(gp + 8 * q);
                    const float g0 = __uint_as_float(gv.x << 16), g1 = __uint_as_float(gv.x & 0xffff0000u), g2 = __uint_as_float(gv.y << 16), g3 = __uint_as_float(gv.y & 0xffff0000u);
                    const float v0 = (acc[i][j][4 * q] - s1[i]) * s2[i] * g0 * sigmoidf_(g0);
                    const float v1 = (acc[i][j][4 * q + 1] - s1[i]) * s2[i] * g1 * sigmoidf_(g1);
                    const float v2 = (acc[i][j][4 * q + 2] - s1[i]) * s2[i] * g2 * sigmoidf_(g2);
                    const float v3 = (acc[i][j][4 * q + 3] - s1[i]) * s2[i] * g3 * sigmoidf_(g3);
                    u32x2 u; u.x = pack2(v0, v1); u.y = pack2(v2, v3);
                    *(u32x2*)(op + 8 * q) = u;
                }
            }
    }
}
DI void phase_scan(const P& p, int l) {
    const int tid_ = tid();
    char* ws_ = launder(p.ws);
    bf16_t* ST = (bf16_t*)(ws_ + OFF_ST);
    const float* misc = (const float*)(ws_ + OFF_MISC);
    for (int idx = blockIdx.x * 512 + tid_; idx < 8 * 16384; idx += gridDim.x * 512) {
        const int seq = idx >> 14, e4 = idx & 16383, h4 = seq >> 1, dir = seq & 1;
        const float cdec = exp2f(misc[8 + l * 8 + dir * 4 + h4] * 256.f);
        bf16_t* base = ST + (size_t)seq * 32 * 65536 + (size_t)e4 * 4;
        float r0 = 0.f, r1 = 0.f, r2 = 0.f, r3 = 0.f;
#pragma unroll 8
        for (int n = 0; n < 32; ++n) {
            uint2* pp = (uint2*)(base + (size_t)n * 65536);
            const uint2 v = *pp;
            r0 = r0 * cdec + __uint_as_float(v.x << 16); r1 = r1 * cdec + __uint_as_float(v.x & 0xffff0000u);
            r2 = r2 * cdec + __uint_as_float(v.y << 16); r3 = r3 * cdec + __uint_as_float(v.y & 0xffff0000u);
            uint2 o; o.x = pack2(r0, r1); o.y = pack2(r2, r3);
            *pp = o;
        }
    }
}
DI void phase_r4(const P& p, int nrows) {
    const int tid_ = tid();
    char* ws_ = launder(p.ws);
    bf16_t* OR = (bf16_t*)(ws_ + OFF_O);
    const bf16_t* Z = (const bf16_t*)(ws_ + OFF_Z);
    const int lane = tid_ & 63, wv = tid_ >> 6;
    for (int idx = blockIdx.x * 8 + wv; idx < nrows * 4; idx += gridDim.x * 8) {
        const int row = idx >> 2, h4 = idx & 3;
        bf16_t* op = OR + (size_t)row * OLD + h4 * 256 + 4 * lane;
        const uint2 ov = *(const uint2*)op;
        const uint2 gv = *(const uint2*)(Z + (size_t)row * ZLD + ZC_RG + h4 * 256 + 4 * lane);
        float v[4] = {__uint_as_float(ov.x << 16), __uint_as_float(ov.x & 0xffff0000u), __uint_as_float(ov.y << 16), __uint_as_float(ov.y & 0xffff0000u)};
        const float g[4] = {__uint_as_float(gv.x << 16), __uint_as_float(gv.x & 0xffff0000u), __uint_as_float(gv.y << 16), __uint_as_float(gv.y & 0xffff0000u)};
        const float mean = wave_sum(v[0] + v[1] + v[2] + v[3]) * (1.f / 256.f);
        float q = 0.f;
#pragma unroll
        for (int i = 0; i < 4; ++i) { const float d = v[i] - mean; q += d * d; }
        const float rstd = rsqrtf(wave_sum(q) * (1.f / 256.f) + 1e-6f);
#pragma unroll
        for (int i = 0; i < 4; ++i) v[i] = (v[i] - mean) * rstd * g[i] * sigmoidf_(g[i]);
        uint2 o; o.x = pack2(v[0], v[1]); o.y = pack2(v[2], v[3]);
        *(uint2*)op = o;
    }
}

DI void phase_s2(const P& p, int l, int b, char* smem) {
    const int nqb = (l == 0) ? 33 : 32, nTB = (l == 0) ? 33 : 32, tb0 = (l == 0) ? 0 : 1;
    const int nDiff = 8 * nqb, nNA = 16 * nqb, nR1 = 256, nR3a = 4 * nTB;
    for (int i = blockIdx.x; i < nDiff; i += gridDim.x) diff_item(p, l, b, i & 7, i >> 3, smem);
    unsigned* ctr = (unsigned*)(p.ws + OFF_BAR) + 32 + l * 4 + b;
    volatile LAS unsigned* slot = (volatile LAS unsigned*)(smem + 147440);
    const int nq = nR3a + nR1 + nNA;
    for (;;) {
        __syncthreads();
        if (threadIdx.x == 0) *slot = xb_add(ctr, 1u);
        __syncthreads();
        int i = (int)*slot;
        if (i >= nq) break;
        const int nNAl = 16 * 32;
        if (i < nNAl) { na_item(p, l, i & 15, i >> 4, smem); continue; }
        i -= nNAl;
        if (i < nR3a) { r3a_tile(p, l, i & 3, tb0 + (i >> 2), smem); continue; }
        i -= nR3a;
        if (i < nR1) { r1_tile(p, i, smem); continue; }
        i -= nR1;
        na_item(p, l, i & 15, 32 + (i >> 4), smem);
    }
}
DI void phase_r3b(const P& p, int l, char* smem) {
    const int nTB = (l == 0) ? 33 : 32, tb0 = (l == 0) ? 0 : 1;
    for (int i = blockIdx.x; i < 8 * nTB; i += gridDim.x) {
        const int mh = i & 1, h4 = (i >> 1) & 3, TB = tb0 + (i >> 3);
        r3b_tile(p, l, h4, TB, mh, smem);
    }
}

template <int MI>
DI void merge_tile(const P& p, size_t ooff, size_t obr, size_t goff, int gld, size_t moff, int m0, int n0, char* smem) {
    const int tid_ = tid();
    char* ws_ = launder(p.ws);
    const bf16_t* O = (const bf16_t*)(ws_ + ooff);
    const bf16_t* WP = (const bf16_t*)(ws_ + OFF_WP);
    const bf16_t* G = (const bf16_t*)(ws_ + goff);
    bf16_t* Mb = (bf16_t*)(ws_ + moff);
    const int t = tid_, w = t >> 6, ln = t & 63, lr = ln & 31, lh = ln >> 5, wm = w >> 2, wn = w & 3;
    f32x16 tot[MI][2];
    zero4(tot);
    for (int br = 0; br < 3; ++br) {
        f32x16 acc[MI][2];
        zero4(acc);
        gemm_kloop<true, MI>(O + (size_t)br * obr + (size_t)m0 * OLD, OLD, WP + (size_t)br * 1024 * WK + (size_t)n0 * WK, WK, D, acc, smem);
#pragma unroll
        for (int i = 0; i < MI; ++i)
#pragma unroll
            for (int j = 0; j < 2; ++j) {
                const int m = m0 + 32 * MI * wm + 32 * i + lr, nb = n0 + 64 * wn + 32 * j + 4 * lh;
                const bf16_t* gp = G + (size_t)m * gld + br * 1024 + nb;
#pragma unroll
                for (int q = 0; q < 4; ++q) {
                    const u32x2 gv = *(const u32x2*)(gp + 8 * q);
                    tot[i][j][4 * q] += __uint_as_float(gv.x << 16) * acc[i][j][4 * q];
                    tot[i][j][4 * q + 1] += __uint_as_float(gv.x & 0xffff0000u) * acc[i][j][4 * q + 1];
                    tot[i][j][4 * q + 2] += __uint_as_float(gv.y << 16) * acc[i][j][4 * q + 2];
                    tot[i][j][4 * q + 3] += __uint_as_float(gv.y & 0xffff0000u) * acc[i][j][4 * q + 3];
                }
            }
    }
    store_swap_bf16(tot, Mb, HLD, m0, n0);
}
DI void phase_merge(const P& p, int l, int b, char* smem) {
    const int nitems = 256 + (l == 0 ? 16 : 0);
    for (int idx = blockIdx.x; idx < nitems; idx += gridDim.x) {
        if (idx < 256) merge_tile<2>(p, OFF_O, (size_t)RB * OLD, OFF_Z + (size_t)ZC_GA * 2, ZLD, OFF_H + (size_t)b * RB * HLD * 2, (idx >> 2) * 128, (idx & 3) * 256, smem);
        else {
            char* ws_ = launder(p.ws);
            const int j = idx - 256, t = tid();
            for (int c = t; c < 16 * 768; c += 512) {
                const int rr = 16 * j + c / 768, k = c % 768;
                if (k < 384) {
                    const int br = k >> 7, cc = (k & 127) * 8;
                    *(u32x4*)((bf16_t*)(ws_ + OFF_OC) + ((size_t)br * 1024 + b * 256 + rr) * OLD + cc) = *(const u32x4*)((const bf16_t*)(ws_ + OFF_O) + ((size_t)br * RB + SEQ + rr) * OLD + cc);
                } else {
                    const int cc = (k - 384) * 8;
                    *(u32x4*)((bf16_t*)(ws_ + OFF_GC) + (size_t)(b * 256 + rr) * 3072 + cc) = *(const u32x4*)((const bf16_t*)(ws_ + OFF_Z) + (size_t)(SEQ + rr) * ZLD + ZC_GA + cc);
                }
            }
        }
    }
}
template <int MI>
DI void wo_tile(const P& p, size_t moff, int m0, int n0, char* smem) {
    char* ws_ = launder(p.ws);
    const bf16_t* Mb = (const bf16_t*)(ws_ + moff);
    const bf16_t* W = (const bf16_t*)(ws_ + OFF_WO);
    float* Y = (float*)(ws_ + OFF_ST);
    f32x16 acc[MI][2]; zero4(acc);
    gemm_kloop<true, MI>(Mb + (size_t)m0 * HLD, HLD, W + (size_t)n0 * WK, WK, D, acc, smem);
    store_swap_f32(acc, Y, D, m0, n0);
}
DI void phase_wo(const P& p, int b, char* smem) {
    for (int idx = blockIdx.x; idx < 256; idx += gridDim.x) wo_tile<2>(p, OFF_H + (size_t)b * RB * HLD * 2, (idx >> 2) * 128, (idx & 3) * 256, smem);
}
template <int MI>
DI void ff1_tile(const P& p, size_t hoff, int m0, int n0, char* smem) {
    char* ws_ = launder(p.ws);
    const bf16_t* Hb = (const bf16_t*)(ws_ + hoff);
    const bf16_t* W = (const bf16_t*)(ws_ + OFF_WF1);
    bf16_t* U = (bf16_t*)(ws_ + OFF_Z);
    f32x16 acc[MI][2]; zero4(acc);
    gemm_kloop<true, MI>(Hb + (size_t)m0 * HLD, HLD, W + (size_t)n0 * WK, WK, D, acc, smem);
#pragma unroll
    for (int i = 0; i < MI; ++i)
#pragma unroll
        for (int j = 0; j < 2; ++j)
#pragma unroll
            for (int e = 0; e < 16; ++e) { const float v = fmaxf(acc[i][j][e], 0.f); acc[i][j][e] = v * v; }
    store_swap_bf16(acc, U, ULD, m0, n0);
}
DI void phase_ff1(const P& p, int b, char* smem) {
    for (int idx = blockIdx.x; idx < 512; idx += gridDim.x) ff1_tile<4>(p, OFF_H + (size_t)b * RB * HLD * 2, (idx >> 4) * 256, (idx & 15) * 256, smem);
}
template <int MI>
DI void ff2_tile(const P& p, int m0, int n0, char* smem) {
    char* ws_ = launder(p.ws);
    const bf16_t* U = (const bf16_t*)(ws_ + OFF_Z);
    const bf16_t* W = (const bf16_t*)(ws_ + OFF_WF2);
    float* Y2 = (float*)(ws_ + OFF_ST);
    f32x16 acc[MI][2]; zero4(acc);
    gemm_kloop<true, MI>(U + (size_t)m0 * ULD, ULD, W + (size_t)n0 * WK2, WK2, DFF, acc, smem);
    store_swap_f32(acc, Y2, D, m0, n0);
}
DI void phase_ff2(const P& p, char* smem) {
    for (int idx = blockIdx.x; idx < 256; idx += gridDim.x) ff2_tile<2>(p, (idx >> 2) * 128, (idx & 3) * 256, smem);
}

#ifndef PHASE_MASK
#define PHASE_MASK 0xffffffffu
#endif
#define PH(n, call) do { if ((PHASE_MASK >> (n)) & 1u) { call; } } while (0)
__global__ void __launch_bounds__(512, 2) fwd_megakernel(P p) {
    __shared__ __attribute__((aligned(16))) char smem[147456];
    __shared__ uint4 xb_words;
    cg::grid_group grid = cg::this_grid();
    if (threadIdx.x == 0) xb_words = make_uint4(0u, 0u, 0u, 0u);
    __syncthreads();
    XcdBarrier bar = xcd_barrier_post((unsigned*)(p.ws + OFF_BAR), (volatile LAS unsigned*)&xb_words);

    PH(0, phase_convert(p, 0, smem));
    PH(1, phase_tables(p));
    PH(1, phase_misc(p));
    PH(2, phase_mod(p, smem));
    grid.sync();
    PH(3, phase_lnmod0(p));
    xcd_barrier(bar);
#pragma unroll 1
    for (int l = 0; l < 2; ++l) {
        if (l == 1) { PH(0, phase_convert(p, 1, smem)); xcd_barrier(bar); }
#pragma unroll 1
        for (int b = 0; b <= NBATCH; ++b) {
            if (b > 0) PH(14, phase_ln2(p, l, b - 1, SEQ, 0));
            if (b < NBATCH) PH(4, phase_inproj(p, l, b, smem));
            xcd_barrier(bar);
            if (b == NBATCH) break;
            PH(5, phase_s2(p, l, b, smem));          xcd_barrier(bar);
            PH(6, phase_scan(p, l));              xcd_barrier(bar);
            PH(7, phase_r3b(p, l, smem));         xcd_barrier(bar);
            PH(9, phase_merge(p, l, b, smem));    xcd_barrier(bar);
            PH(10, phase_wo(p, b, smem));         xcd_barrier(bar);
            PH(11, phase_ln1(p, l, b, SEQ, 0));   xcd_barrier(bar);
            PH(12, phase_ff1(p, b, smem));        xcd_barrier(bar);
            PH(13, phase_ff2(p, smem));           xcd_barrier(bar);
        }
        if (l == 0) {
            constexpr size_t MC = OFF_KT, HC = OFF_KT + (4u << 20);
            for (int idx = blockIdx.x; idx < 64; idx += gridDim.x)
                merge_tile<1>(p, OFF_OC, (size_t)1024 * OLD, OFF_GC, 3072, MC, (idx >> 2) * 64, (idx & 3) * 256, smem);
            xcd_barrier(bar);
            for (int idx = blockIdx.x; idx < 64; idx += gridDim.x) wo_tile<1>(p, MC, (idx >> 2) * 64, (idx & 3) * 256, smem);
            xcd_barrier(bar);
            phase_ln1(p, 0, 0, 1024, 1);
            xcd_barrier(bar);
            for (int idx = blockIdx.x; idx < 256; idx += gridDim.x) ff1_tile<1>(p, HC, (idx >> 4) * 64, (idx & 15) * 256, smem);
            xcd_barrier(bar);
            for (int idx = blockIdx.x; idx < 64; idx += gridDim.x) ff2_tile<1>(p, (idx >> 2) * 64, (idx & 3) * 256, smem);
            xcd_barrier(bar);
            phase_ln2(p, 0, 0, 1024, 1);
            xcd_barrier(bar);
        }
    }
}

extern "C" void kernel_launch(void* const* d_in, const int* in_sizes, int n_in, void* d_out, int out_size, void* d_ws, size_t ws_size, hipStream_t stream) {
    static int grid_blocks = 0;
    if (!grid_blocks) {
        int dev = 0, cus = 0, per_cu = 0;
        hipGetDevice(&dev);
        hipDeviceGetAttribute(&cus, hipDeviceAttributeMultiprocessorCount, dev);
        hipOccupancyMaxActiveBlocksPerMultiprocessor(&per_cu, fwd_megakernel, 512, 0);
        if (per_cu > 1) per_cu = 1;
        if (per_cu < 1) per_cu = 1;
        grid_blocks = cus * per_cu;
    }
    if (ws_size < WS_NEED) { fprintf(stderr, "workspace too small: %zu < %zu\n", ws_size, (size_t)WS_NEED); return; }
    P p{};
    const float** pp = (const float**)&p;
    for (int i = 0; i < 25; ++i) pp[i] = (const float*)d_in[i];
    p.out = (float*)d_out;
    p.ws = (char*)d_ws;
    hipMemsetAsync((char*)d_ws + OFF_BAR, 0, 16384, stream);
    void* args[] = {&p};
    hipError_t e = hipLaunchCooperativeKernel((void*)fwd_megakernel, dim3(grid_blocks), dim3(512), args, 0, stream);
    if (e != hipSuccess) fprintf(stderr, "cooperative launch failed: %s (grid %d)\n", hipGetErrorString(e), grid_blocks);
}
```
